# Optimizing an MI355X kernel written in HIP

```python
import math
import jax, jax.numpy as jnp
from jax import lax
import numpy as np

D_MODEL = 2048
BATCH = 4
SEQ = 4096
DEPTH = 4

HEAD_DIM = 128
N_BRANCH = 4
RET_HEADS = 4
RET_WIDTH = RET_HEADS * HEAD_DIM
RET_CHUNK = 128
ROPE_BASE = 10000.0
DSA_HEADS = 4
DSA_WIDTH = DSA_HEADS * HEAD_DIM
DSA_Q_RANK = 384
IDX_HEADS = 16
IDX_DIM = 64
TOPK_MAX = 256
FOX_HEADS = 4
FOX_WIDTH = FOX_HEADS * HEAD_DIM
GDN_HEADS = 4
GDN_WIDTH = GDN_HEADS * HEAD_DIM
GDN_CONV = 4
GDN_CHUNK = 64
Q_BLOCK = 128
REL_BUCKETS = 32
REL_MAX_DIST = 128
D_FF = 5632
FFN_CONV = 3
EPS = 1e-6

IN_SIZES = (RET_WIDTH, RET_WIDTH, RET_WIDTH, RET_WIDTH,
            DSA_Q_RANK, HEAD_DIM, HEAD_DIM, IDX_DIM, IDX_HEADS,
            FOX_WIDTH, FOX_WIDTH, FOX_WIDTH, FOX_HEADS,
            GDN_WIDTH, GDN_WIDTH, GDN_WIDTH, GDN_WIDTH, GDN_HEADS, GDN_HEADS,
            N_BRANCH * D_MODEL)
IN_COLS = sum(IN_SIZES)

kernel_name = "hybrid_gated_parallel_mixers"

F32 = jnp.float32


def rmsnorm(x, g):
    xf = x.astype(F32)
    y = xf * lax.rsqrt(jnp.mean(xf * xf, axis=-1, keepdims=True) + EPS)
    return (y * g.astype(F32)).astype(x.dtype)


def l2norm(x):
    return x * lax.rsqrt(jnp.sum(x * x, axis=-1, keepdims=True) + EPS)


def causal_dwconv(x, w):
    k, s = w.shape[0], x.shape[1]
    xp = jnp.pad(x, ((0, 0), (k - 1, 0), (0, 0)))
    return sum(xp[:, i:i + s] * w[i] for i in range(k))


def rotary(x, pos):
    half = x.shape[-1] // 2
    inv = 1.0 / (ROPE_BASE ** (jnp.arange(half, dtype=F32) / half))
    ang = pos.astype(F32)[:, None] * inv[None, :]
    cos, sin = jnp.cos(ang)[None, :, None, :], jnp.sin(ang)[None, :, None, :]
    xf = x.astype(F32)
    x1, x2 = xf[..., :half], xf[..., half:]
    return jnp.concatenate([x1 * cos - x2 * sin, x1 * sin + x2 * cos], axis=-1).astype(x.dtype)


def t5_bucket(rel):
    rel = jnp.maximum(rel, 0)
    max_exact = REL_BUCKETS // 2
    relf = jnp.maximum(rel, max_exact).astype(F32)
    large = max_exact + (jnp.log(relf / max_exact) / math.log(REL_MAX_DIST / max_exact)
                         * (REL_BUCKETS - max_exact)).astype(jnp.int32)
    large = jnp.minimum(large, REL_BUCKETS - 1)
    return jnp.where(rel < max_exact, rel, large)


def query_blocks(t):
    b, s = t.shape[0], t.shape[1]
    return jnp.moveaxis(t.reshape(b, s // Q_BLOCK, Q_BLOCK, *t.shape[2:]), 1, 0)


def retention(q, k, v, gate):
    b, s, _ = q.shape
    c = RET_CHUNK
    nc = s // c
    pos = jnp.arange(s)
    heads = lambda t: t.reshape(b, s, RET_HEADS, HEAD_DIM)
    chunks = lambda t: t.reshape(b, nc, c, RET_HEADS, HEAD_DIM)
    qf = chunks(rotary(heads(q), pos).astype(F32))
    kf = chunks(rotary(heads(k), pos).astype(F32) * HEAD_DIM ** -0.5)
    vf = chunks(heads(v).astype(F32))
    log_gamma = jnp.log1p(-jnp.exp2(-5.0 - jnp.arange(RET_HEADS, dtype=F32)))
    n = jnp.arange(c, dtype=F32)
    diff = n[:, None] - n[None, :]
    decay = jnp.where(diff >= 0, jnp.exp(log_gamma[:, None, None] * jnp.maximum(diff, 0.0)), 0.0)
    inner = jnp.einsum('bnqhd,bnkhd->bnhqk', qf, kf) * decay
    o_inner = jnp.einsum('bnhqk,bnkhd->bnqhd', inner, vf)
    zeta = jnp.exp(log_gamma[None, :] * (c - 1 - n)[:, None])
    chunk_kv = jnp.einsum('bnchd,bnche->bnhde', kf * zeta[:, :, None], vf)
    gamma_c = jnp.exp(log_gamma * c)[:, None, None]

    def step(r, kv):
        return r * gamma_c + kv, r

    _, r_prev = lax.scan(step, jnp.zeros_like(chunk_kv[:, 0]), jnp.moveaxis(chunk_kv, 1, 0))
    r_prev = jnp.moveaxis(r_prev, 0, 1)
    xi = jnp.exp(log_gamma[None, :] * (n + 1)[:, None])
    o_cross = jnp.einsum('bnchd,bnhde->bnche', qf, r_prev) * xi[:, :, None]
    o = (o_inner + o_cross).reshape(b, s, RET_HEADS, HEAD_DIM)
    mu = jnp.mean(o, axis=-1, keepdims=True)
    var = jnp.mean((o - mu) ** 2, axis=-1, keepdims=True)
    o = ((o - mu) * lax.rsqrt(var + EPS)).reshape(b, s, RET_WIDTH)
    return (jax.nn.silu(gate.astype(F32)) * o).astype(gate.dtype)


def dsa_attention(c_q, k, v, k_idx, w_idx, cq_norm, w_uq, w_qidx, rel_bias):
    b, s, _ = c_q.shape
    c_q = rmsnorm(c_q, cq_norm)
    q = (c_q @ w_uq).reshape(b, s, DSA_HEADS, HEAD_DIM)
    q_idx = (c_q @ w_qidx).reshape(b, s, IDX_HEADS, IDX_DIM)
    w_idx = w_idx * (IDX_HEADS ** -0.5 * IDX_DIM ** -0.5)
    topk = min(TOPK_MAX, s // 4)
    nb = s // Q_BLOCK
    key_pos = jnp.arange(s)
    gather = jax.vmap(lambda table, ids: table[ids])

    def block(args):
        q_b, qi_b, wi_b, start = args
        t = start + jnp.arange(Q_BLOCK)
        causal = key_pos[None, :] <= t[:, None]
        score = jnp.einsum('bqhs,bqh->bqs',
                           jax.nn.relu(jnp.einsum('bqhd,bsd->bqhs', qi_b, k_idx)), wi_b).astype(F32)
        score = jnp.where(causal[None], score, -jnp.inf)
        _, idx = lax.top_k(score, topk)
        valid = idx <= t[None, :, None]
        k_sel = gather(k, idx)
        v_sel = gather(v, idx)
        bias = rel_bias[t5_bucket(t[None, :, None] - idx)]
        logits = (jnp.einsum('bqhd,bqkd->bhqk', q_b, k_sel).astype(F32) * HEAD_DIM ** -0.5
                  + jnp.transpose(bias, (0, 3, 1, 2)).astype(F32))
        logits = jnp.where(valid[:, None], logits, -jnp.inf)
        p = jax.nn.softmax(logits, axis=-1)
        return jnp.einsum('bhqk,bqkd->bqhd', p.astype(v.dtype), v_sel)

    out = lax.map(block, (query_blocks(q), query_blocks(q_idx), query_blocks(w_idx),
                          jnp.arange(nb, dtype=jnp.int32) * Q_BLOCK))
    return jnp.moveaxis(out, 0, 1).reshape(b, s, DSA_WIDTH)


def forgetting_attention(q, k, v, f_logit):
    b, s, _ = q.shape
    heads = lambda t: t.reshape(b, s, FOX_HEADS, HEAD_DIM)
    q, k, v = heads(q), heads(k), heads(v)
    c = jnp.cumsum(jax.nn.log_sigmoid(f_logit.astype(F32)), axis=1)
    c_keys = jnp.moveaxis(c, 1, 2)
    key_pos = jnp.arange(s)
    nb = s // Q_BLOCK

    def block(args):
        q_b, c_b, start = args
        t = start + jnp.arange(Q_BLOCK)
        causal = key_pos[None, :] <= t[:, None]
        forget_bias = jnp.moveaxis(c_b, 1, 2)[..., :, None] - c_keys[:, :, None, :]
        logits = jnp.einsum('bqhd,bshd->bhqs', q_b, k).astype(F32) * HEAD_DIM ** -0.5 + forget_bias
        logits = jnp.where(causal[None, None], logits, -jnp.inf)
        p = jax.nn.softmax(logits, axis=-1)
        return jnp.einsum('bhqs,bshd->bqhd', p.astype(v.dtype), v)

    out = lax.map(block, (query_blocks(q), query_blocks(c), jnp.arange(nb, dtype=jnp.int32) * Q_BLOCK))
    return jnp.moveaxis(out, 0, 1).reshape(b, s, FOX_WIDTH)


def gated_deltanet(q, k, v, z, beta_logit, a_logit, conv_w, a_log, dt_bias, norm_g):
    b, s, _ = q.shape
    c = GDN_CHUNK
    nc = s // c
    qkv = jax.nn.silu(causal_dwconv(jnp.concatenate([q, k, v], axis=-1), conv_w))
    q, k, v = jnp.split(qkv, 3, axis=-1)
    chunks = lambda t: t.reshape(b, nc, c, GDN_HEADS, HEAD_DIM).transpose(0, 3, 1, 2, 4).astype(F32)
    chunks_h = lambda t: t.reshape(b, nc, c, GDN_HEADS).transpose(0, 3, 1, 2).astype(F32)
    qf = l2norm(chunks(q)) * HEAD_DIM ** -0.5
    kf = l2norm(chunks(k))
    vf = chunks(v)
    beta = chunks_h(jax.nn.sigmoid(beta_logit.astype(F32)))
    g = chunks_h(-jnp.exp(a_log.astype(F32)) * jax.nn.softplus(a_logit.astype(F32) + dt_bias.astype(F32)))
    g = jnp.cumsum(g, axis=-1)
    tril = jnp.tril(jnp.ones((c, c), dtype=bool))
    strict = jnp.tril(jnp.ones((c, c), dtype=bool), -1)
    decay = jnp.exp(jnp.where(tril, g[..., :, None] - g[..., None, :], -jnp.inf))
    kk = jnp.einsum('bhncd,bhnsd->bhncs', kf, kf)
    a_mat = jnp.eye(c, dtype=F32) + jnp.where(strict, beta[..., :, None] * kk * decay, 0.0)
    rhs = jnp.concatenate([vf * beta[..., None], kf * (beta * jnp.exp(g))[..., None]], axis=-1)
    sol = lax.linalg.triangular_solve(a_mat, rhs, left_side=True, lower=True)
    u0, kcum = jnp.split(sol, 2, axis=-1)
    qk = jnp.einsum('bhncd,bhnsd->bhncs', qf, kf) * decay
    q_dec = qf * jnp.exp(g)[..., None]
    g_last = g[..., -1]
    k_dec = kf * jnp.exp(g_last[..., None] - g)[..., None]

    def step(state, xs):
        u0_c, kcum_c, qk_c, qdec_c, kdec_c, glast_c = xs
        v_new = u0_c - jnp.einsum('bhcd,bhde->bhce', kcum_c, state)
        o = jnp.einsum('bhcd,bhde->bhce', qdec_c, state) + jnp.einsum('bhcs,bhse->bhce', qk_c, v_new)
        state = state * jnp.exp(glast_c)[..., None, None] + jnp.einsum('bhcd,bhce->bhde', kdec_c, v_new)
        return state, o

    xs = tuple(jnp.moveaxis(t, 2, 0) for t in (u0, kcum, qk, q_dec, k_dec, g_last))
    _, o = lax.scan(step, jnp.zeros((b, GDN_HEADS, HEAD_DIM, HEAD_DIM), F32), xs)
    o = o.transpose(1, 0, 3, 2, 4).reshape(b, s, GDN_HEADS, HEAD_DIM)
    o = rmsnorm(o, norm_g).reshape(b, s, GDN_WIDTH)
    return (o * jax.nn.silu(z.astype(F32))).astype(z.dtype)


def hybrid_mixer(h, w_in, dsa_cq_norm, dsa_w_uq, dsa_w_qidx, fox_f_bias,
                 gdn_conv, gdn_a_log, gdn_dt_bias, gdn_norm, w_branch, w_out, rel_bias):
    b, s, _ = h.shape
    proj = h @ w_in
    split_at = np.cumsum(IN_SIZES)[:-1].tolist()
    (r_q, r_k, r_v, r_g,
     d_cq, d_k, d_v, i_k, i_w,
     f_q, f_k, f_v, f_f,
     g_q, g_k, g_v, g_z, g_b, g_a,
     mix_gates) = jnp.split(proj, split_at, axis=-1)
    o_ret = retention(r_q, r_k, r_v, r_g)
    o_dsa = dsa_attention(d_cq, d_k, d_v, i_k, i_w, dsa_cq_norm, dsa_w_uq, dsa_w_qidx, rel_bias)
    o_fox = forgetting_attention(f_q, f_k, f_v, f_f + fox_f_bias)
    o_gdn = gated_deltanet(g_q, g_k, g_v, g_z, g_b, g_a, gdn_conv, gdn_a_log, gdn_dt_bias, gdn_norm)
    branches = jnp.stack([o_ret, o_dsa, o_fox, o_gdn], axis=2)
    wide = jnp.einsum('bsnw,nwd->bsnd', branches, w_branch)
    gates = jax.nn.sigmoid(mix_gates.reshape(b, s, N_BRANCH, D_MODEL))
    return jnp.einsum('bsnd,bsnd->bsd', gates, wide) @ w_out


def conv_ffn(h, w_gate, w_up, conv_w, conv_b, w_down):
    a = jax.nn.silu(causal_dwconv(h @ w_gate, conv_w) + conv_b)
    return (a * (h @ w_up)) @ w_down


def setup_inputs(seed: int = 0) -> dict:
    key = jax.random.key(seed)
    ks = jax.random.split(key, 24)
    L, D = DEPTH, D_MODEL
    nrm = lambda k, shape, scale: jax.random.normal(k, shape, F32) * scale
    gain = lambda k, shape: 1.0 + 0.02 * jax.random.normal(k, shape, F32)
    dt = jax.random.uniform(ks[10], (L, GDN_HEADS), F32, 1e-3, 1e-1)
    return {
        "x": nrm(ks[0], (BATCH, SEQ, D), 1.0),
        "norm_mix": gain(ks[1], (L, D)),
        "w_in": nrm(ks[2], (L, D, IN_COLS), D ** -0.5),
        "dsa_cq_norm": gain(ks[3], (L, DSA_Q_RANK)),
        "dsa_w_uq": nrm(ks[4], (L, DSA_Q_RANK, DSA_WIDTH), DSA_Q_RANK ** -0.5),
        "dsa_w_qidx": nrm(ks[5], (L, DSA_Q_RANK, IDX_HEADS * IDX_DIM), DSA_Q_RANK ** -0.5),
        "fox_f_bias": 3.0 + 0.5 * jax.random.normal(ks[6], (L, FOX_HEADS), F32),
        "gdn_conv": nrm(ks[7], (L, GDN_CONV, 3 * GDN_WIDTH), GDN_CONV ** -0.5),
        "gdn_a_log": jnp.log(jax.random.uniform(ks[8], (L, GDN_HEADS), F32, 1.0, 16.0)),
        "gdn_dt_bias": jnp.log(jnp.expm1(dt)),
        "gdn_norm": gain(ks[9], (L, HEAD_DIM)),
        "w_branch": nrm(ks[11], (L, N_BRANCH, 512, D), 512 ** -0.5),
        "w_out": nrm(ks[12], (L, D, D), D ** -0.5),
        "rel_bias": nrm(ks[13], (REL_BUCKETS, DSA_HEADS), 0.5),
        "norm_ffn": gain(ks[14], (L, D)),
        "ffn_w_gate": nrm(ks[15], (L, D, D_FF), D ** -0.5),
        "ffn_w_up": nrm(ks[16], (L, D, D_FF), D ** -0.5),
        "ffn_conv": nrm(ks[17], (L, FFN_CONV, D_FF), FFN_CONV ** -0.5),
        "ffn_conv_b": nrm(ks[18], (L, D_FF), 0.02),
        "ffn_w_down": nrm(ks[19], (L, D_FF, D), D_FF ** -0.5),
        "final_norm": gain(ks[20], (D,)),
    }


def reference(x, norm_mix, w_in, dsa_cq_norm, dsa_w_uq, dsa_w_qidx, fox_f_bias,
              gdn_conv, gdn_a_log, gdn_dt_bias, gdn_norm, w_branch, w_out, rel_bias,
              norm_ffn, ffn_w_gate, ffn_w_up, ffn_conv, ffn_conv_b, ffn_w_down, final_norm):
    for l in range(DEPTH):
        x = x + hybrid_mixer(rmsnorm(x, norm_mix[l]), w_in[l], dsa_cq_norm[l], dsa_w_uq[l],
                             dsa_w_qidx[l], fox_f_bias[l], gdn_conv[l], gdn_a_log[l],
                             gdn_dt_bias[l], gdn_norm[l], w_branch[l], w_out[l], rel_bias)
        x = x + conv_ffn(rmsnorm(x, norm_ffn[l]), ffn_w_gate[l], ffn_w_up[l], ffn_conv[l],
                         ffn_conv_b[l], ffn_w_down[l])
    return rmsnorm(x, final_norm)
```

```cpp
#include <hip/hip_runtime.h>
#include <cstdio>
#include <cstdint>

#define LAS __attribute__((address_space(3)))
typedef unsigned short bf16_t;
typedef short bf16x8 __attribute__((ext_vector_type(8)));
typedef short s16x4 __attribute__((ext_vector_type(4)));
typedef float f32x2 __attribute__((ext_vector_type(2)));
typedef float f32x4 __attribute__((ext_vector_type(4)));
typedef float f32x16 __attribute__((ext_vector_type(16)));
typedef unsigned u32x2 __attribute__((ext_vector_type(2)));
typedef unsigned u32x4 __attribute__((ext_vector_type(4)));
typedef __bf16 hbf2 __attribute__((ext_vector_type(2)));
#define DI __device__ __forceinline__

constexpr int D = 2048, BATCH = 4, SEQ = 4096, DEPTH = 4, M = BATCH * SEQ;
constexpr int NP = 14592, FF = 5632, NSRC = 14556;
constexpr float EPS = 1e-6f;
constexpr int C_RQ = 0, C_RK = 512, C_RV = 1024, C_RG = 1536, C_FQ = 2048, C_FK = 2560, C_FV = 3072, C_GQ = 3584, C_GK = 4096, C_GV = 4608, C_GZ = 5120,
              C_DCQ = 5632, C_DK = 6016, C_DV = 6144, C_IK = 6272, C_IW = 6336, C_FF = 6352, C_GB = 6356, C_GA = 6360, C_GATE = 6400;
__host__ __device__ constexpr int src_col(int j) {
    return j < 2048 ? j : j < 3584 ? 2768 + (j - 2048) : j < 5632 ? 4308 + (j - 3584) : j < 6352 ? 2048 + (j - 5632) : j < 6356 ? 4304 + (j - 6352)
         : j < 6364 ? j : j < 6400 ? -1 : 6364 + (j - 6400);
}
constexpr int O_RET = 0, O_DSA = 512, O_FOX = 1024, O_GDN = 1536;
constexpr int VT_ROWS = 1152, VT_RET = 0, VT_FOX = 512, VT_DSA = 1024;

constexpr size_t MiB = 1u << 20;
constexpr size_t WS_CTL = 0, CTL_BYTES = 128 * 1024;
constexpr size_t WS_ROPE = 1 * MiB;
constexpr size_t WS_BT = 3 * MiB;
constexpr size_t WS_WIN = 4 * MiB;
constexpr size_t WS_WG8 = 30 * MiB;
constexpr size_t WS_WBR = 61 * MiB;
constexpr size_t WS_WOUT = 69 * MiB;
constexpr size_t WS_WDSA = 77 * MiB;
constexpr size_t WS_H = 80 * MiB;
constexpr size_t WS_PROJ = 144 * MiB;
constexpr size_t WS_G = WS_PROJ, WS_ACT = WS_PROJ + 176 * MiB;
constexpr size_t WS_BR = 600 * MiB;
constexpr size_t WS_RQ = 664 * MiB, WS_RK = 680 * MiB;
constexpr int VT_LD = SEQ + 128, SC_LD = SEQ + 64;
constexpr size_t WS_VT = 696 * MiB;
constexpr size_t WS_QD = 734 * MiB;
constexpr size_t WS_SC = 782 * MiB;
constexpr size_t WS_WG = WS_SC, WS_WU = WS_SC + 22 * MiB, WS_WD = WS_SC + 44 * MiB;
constexpr size_t WS_MASK = 1042 * MiB;
constexpr size_t WS_U0 = 1050 * MiB;
constexpr size_t WS_KCUM = 1082 * MiB;
constexpr size_t WS_QDEC = 1098 * MiB;
constexpr size_t WS_KDT = 1114 * MiB;
constexpr size_t WS_QKM = 1130 * MiB;
constexpr size_t WS_OG = 1138 * MiB;
constexpr size_t WS_SMALL = 1170 * MiB;
constexpr size_t WS_CFOX = WS_SMALL, WS_RDSA = WS_SMALL + 256 * 1024, WS_EGL = WS_SMALL + 320 * 1024;
constexpr size_t WS_RSP1 = 1172 * MiB, WS_RSP2 = 1174 * MiB;
constexpr size_t WS_RF = 1176 * MiB;
constexpr size_t WS_XB8 = 1177 * MiB;
constexpr size_t WS_KVT = 1209 * MiB;
constexpr size_t WS_END = 1241 * MiB;
static_assert(WS_VT + (size_t)BATCH * 1152 * VT_LD * 2 <= WS_QD && WS_SC + (size_t)M * SC_LD * 4 <= WS_MASK, "ws map");

constexpr int CW_BAR = 4096;
constexpr int CW_Q = 16384;

constexpr int LDS_BYTES = 136 * 1024;
constexpr int LDS_MISC = 132 * 1024;

DI float bf2f(bf16_t v) { return __uint_as_float(((unsigned)v) << 16); }
DI unsigned pk2(float lo, float hi) { f32x2 v = {lo, hi}; hbf2 r = __builtin_convertvector(v, hbf2); return __builtin_bit_cast(unsigned, r); }
DI bf16_t f2bf(float f) { return (bf16_t)(pk2(f, 0.f) & 0xffffu); }
DI float lo_bf(unsigned w) { return __uint_as_float(w << 16); }
DI float hi_bf(unsigned w) { return __uint_as_float(w & 0xffff0000u); }
DI bf16x8 pack8(float a0, float a1, float a2, float a3, float a4, float a5, float a6, float a7) {
    u32x4 w = {pk2(a0, a1), pk2(a2, a3), pk2(a4, a5), pk2(a6, a7)}; return __builtin_bit_cast(bf16x8, w);
}
DI float wave_sum(float v) {
#pragma unroll
    for (int o = 1; o < 64; o <<= 1) v += __shfl_xor(v, o);
    return v;
}
DI float sigmoidf_(float x) { return 1.f / (1.f + __expf(-x)); }
DI float siluf_(float x) { return x / (1.f + __expf(-x)); }
typedef int v8i __attribute__((ext_vector_type(8)));
typedef int v4i __attribute__((ext_vector_type(4)));
DI unsigned pk4_fp8(float a, float b, float c_, float d) {
    a = fminf(fmaxf(a, -448.f), 448.f); b = fminf(fmaxf(b, -448.f), 448.f); c_ = fminf(fmaxf(c_, -448.f), 448.f); d = fminf(fmaxf(d, -448.f), 448.f);
    int p = 0; p = __builtin_amdgcn_cvt_pk_fp8_f32(a, b, p, false); p = __builtin_amdgcn_cvt_pk_fp8_f32(c_, d, p, true); return (unsigned)p; }
#define MFMA32(a, b, c) __builtin_amdgcn_mfma_f32_32x32x16_bf16((a), (b), (c), 0, 0, 0)
DI int crow(int r, int hf) { return (r & 3) + 8 * (r >> 2) + 4 * hf; }
DI void rs_factors8(const float* rf_, int row0, int  , float (&rf)[2][4]) {
#pragma unroll
    for (int ai = 0; ai < 2; ++ai)
#pragma unroll
        for (int m = 0; m < 4; ++m) rf[ai][m] = rf_[row0 + ai * 128 + m * 16];
}

#define XB_TMO      128
#define XB_XCNT(j)  (256  + 64 * (j))
#define XB_XSUB(j)  (1280 + 64 * (j))
#define XB_XGEN(j)  (2304 + 64 * (j))
#define XB_TOP      3328
#define XB_TOPGEN   3392
#define XCD_BAR_WORDS 3456
#define XB_SPIN_CAP (1u << 21)
__device__ __forceinline__ unsigned xb_ld(unsigned* p)              { return __hip_atomic_load(p, __ATOMIC_RELAXED, __HIP_MEMORY_SCOPE_AGENT); }
__device__ __forceinline__ unsigned xb_add(unsigned* p, unsigned v) { return __hip_atomic_fetch_add(p, v, __ATOMIC_RELAXED, __HIP_MEMORY_SCOPE_AGENT); }
__device__ __forceinline__ unsigned xb_xcc_id() { return (unsigned)__builtin_amdgcn_s_getreg((3 << 11) | 20) & 0xFu; }
#define XB_SPIN(cond, bar) do { unsigned _sp = 0; while (cond) { __builtin_amdgcn_s_sleep(1); \
    if ((++_sp & 255u) == 0u) { if (xb_ld(&(bar)[XB_TMO])) break; if (_sp > XB_SPIN_CAP) { atomicAdd(&(bar)[XB_TMO], 1u); break; } } } } while (0)
struct XcdBarrier { unsigned* bar; unsigned x; volatile LAS unsigned* st; };
__device__ __forceinline__ XcdBarrier xcd_barrier_post(unsigned* bar, volatile LAS unsigned* st) {
    XcdBarrier b; b.bar = bar; b.x = xb_xcc_id(); b.st = st;
    if (threadIdx.x == 0) (void)xb_add(&bar[XB_XCNT(b.x)], 1u);
    return b;
}
__device__ __forceinline__ void xcd_barrier_complete(unsigned* bar, unsigned x, unsigned& nloc, unsigned& nx) {
    const unsigned G = gridDim.x * gridDim.y * gridDim.z;
    unsigned sum, cnt, mine, sp = 0u;
    for (;;) {
        sum = 0u; cnt = 0u; mine = 0u;
#pragma unroll
        for (unsigned j = 0; j < 16; ++j) { const unsigned c = xb_ld(&bar[XB_XCNT(j)]); sum += c; cnt += (c > 0u) ? 1u : 0u; mine = (j == x) ? c : mine; }
        if (sum == G) break;
        __builtin_amdgcn_s_sleep(1);
        if ((++sp & 255u) == 0u) { if (xb_ld(&bar[XB_TMO])) break; if (sp > XB_SPIN_CAP) { atomicAdd(&bar[XB_TMO], 1u); break; } }
    }
    nloc = mine > 0u ? mine : 1u; nx = cnt > 0u ? cnt : 1u;
}
__device__ __forceinline__ void xcd_barrier(const XcdBarrier& b) {
    asm volatile("s_waitcnt vmcnt(0)" ::: "memory");
    __syncthreads();
    if (threadIdx.x == 0) {
        unsigned* bar = b.bar;
        __builtin_amdgcn_s_waitcnt(0);
        unsigned nloc = b.st[0], nx = b.st[1];
        if (nloc == 0u) { xcd_barrier_complete(bar, b.x, nloc, nx); b.st[0] = nloc; b.st[1] = nx; }
        const unsigned old = xb_add(&bar[XB_XSUB(b.x)], 1u);
        const unsigned gen = old / nloc;
        if (old + 1u == (gen + 1u) * nloc) {
            __builtin_amdgcn_fence(__ATOMIC_RELEASE, "agent");
            asm volatile("s_waitcnt vmcnt(0)" ::: "memory");
            const unsigned og = xb_add(&bar[XB_TOP], 1u);
            const unsigned tg = og / nx;
            if (og + 1u == (tg + 1u) * nx) xb_add(&bar[XB_TOPGEN], 1u);
            else XB_SPIN(xb_ld(&bar[XB_TOPGEN]) == tg, bar);
            __builtin_amdgcn_fence(__ATOMIC_ACQUIRE, "agent");
            xb_add(&bar[XB_XGEN(b.x)], 1u);
            asm volatile("s_waitcnt vmcnt(0)" ::: "memory");
        } else {
            XB_SPIN(xb_ld(&bar[XB_XGEN(b.x)]) == gen, bar);
            __builtin_amdgcn_fence(__ATOMIC_ACQUIRE, "agent");
            asm volatile("s_waitcnt vmcnt(0)" ::: "memory");
        }
    }
    __syncthreads();
}

namespace pg8 {
constexpr int BM = 256, BK = 64, HALF = 128, HTB = HALF * BK * 2, STAGE_BYTES = 8 * HTB, NXCD = 8, WGM = 8;
__host__ __device__ __forceinline__ int lds_byte(int r, int c) { const int st = (r >> 4) * 2 + (c >> 5), rr = r & 15, cc = c & 31, ob = rr * 64 + cc * 2; return st * 1024 + (ob ^ (((ob >> 9) & 1) << 5)); }
__host__ __device__ __forceinline__ void stage_rc(int b, int& R, int& C) { const int st = b / 1024, sb = b % 1024, swz = sb ^ (((sb >> 9) & 1) << 5); R = (st >> 1) * 16 + swz / 64; C = (st & 1) * 32 + (swz % 64) / 2; }
__host__ __device__ __forceinline__ int perm32(int rho) { const int n = rho >> 4, i = rho & 15; return 8 * (i >> 2) + 4 * n + (i & 3); }
struct Unit { int pm, pn, sub; };
struct Gemm { const bf16_t* A; const bf16_t* Bt; int lda, K; size_t subA, subB; };
struct Sched {
    int nM, nN, nwg, G, c, nsub;
    __device__ void init(int M_, int N_, int G_, int c_, int nsub_) { nM = M_ / BM; nN = N_ / BM; nwg = nM * nN; G = G_; c = c_; nsub = nsub_; }
    __device__ bool next(int i, Unit& u) const {
        const int ti = i / nsub; u.sub = i - ti * nsub;
        const long L = (long)ti * G + c; if (L >= nwg) return false;
        int wgid = (int)L; { const int q = nwg / NXCD, r = nwg % NXCD, xcd = wgid % NXCD, off = wgid / NXCD; wgid = (xcd < r ? xcd * (q + 1) : r * (q + 1) + (xcd - r) * q) + off; }
        const int nig = WGM * nN, gid = wgid / nig, fm = gid * WGM, gsz = (nM - fm) < WGM ? (nM - fm) : WGM;
        u.pm = fm + ((wgid % nig) % gsz); u.pn = (wgid % nig) / gsz; return true;
    }
};
template <class Epi, bool ALIGN_EPI = true, bool FP8 = false>
__device__ __forceinline__ void gemm_phase(LAS unsigned char* lds, const Gemm g, const Sched& S, const Epi& E, const int tid) {
    const int wid = __builtin_amdgcn_readfirstlane(tid >> 6), lane = tid & 63, wr = wid >> 2, wc = wid & 3, fr = lane & 15, fq = lane >> 4;
    const int K = g.K, nt = K / BK, lda = g.lda;
    unsigned voffA[2], voffB[2];
#pragma unroll
    for (int i = 0; i < 2; ++i) { int R, C; stage_rc(tid * 16 + i * 8192, R, C); const int Rb = Epi::PERM ? ((R & ~31) + perm32(R & 31)) : R;
        voffA[i] = (unsigned)(R * lda + C) * 2u; voffB[i] = (unsigned)(Rb * K + C) * 2u; }
    const size_t kstep = (size_t)(BK * 2);
    const size_t hstepA = (size_t)HALF * lda * 2, hstepB = (size_t)HALF * K * 2;
    const size_t tstepA = 2 * hstepA, tstepB = 2 * hstepB;
    const unsigned ldsw = (unsigned)wid * 1024u;
    const int aoff = lds_byte(wr * 64 + fr, fq * 8), boff = lds_byte(wc * 32 + fr, fq * 8);
#define PG8_SA(b, h) (((b) * 2 + (h)) * HTB)
#define PG8_SB(b, h) ((4 + (b) * 2 + (h)) * HTB)
#define PG8_STAGE(bufoff, gbase, voff) do { _Pragma("unroll") for (int _i = 0; _i < 2; ++_i) \
        __builtin_amdgcn_global_load_lds((const unsigned*)((const char*)(gbase) + (voff)[_i]), (LAS unsigned*)(lds + (bufoff) + ldsw + _i * 8192), 16, 0, 0); } while (0)
#define PG8_LD8(off) __builtin_shufflevector(*(const LAS v4i*)(lds + (off)), *(const LAS v4i*)(lds + (off) + 1024), 0, 1, 2, 3, 4, 5, 6, 7)
#define PG8_LDA(dst, b, h) do { if constexpr (FP8) { _Pragma("unroll") for (int m = 0; m < 4; ++m) dst##8[m] = PG8_LD8(PG8_SA(b, h) + aoff + m * 2048); } else { \
        _Pragma("unroll") for (int m = 0; m < 4; ++m) _Pragma("unroll") for (int k = 0; k < 2; ++k) dst[m][k] = *(const LAS bf16x8*)(lds + PG8_SA(b, h) + aoff + m * 2048 + k * 1024); } } while (0)
#define PG8_LDB(dst, b, h) do { if constexpr (FP8) { _Pragma("unroll") for (int n = 0; n < 2; ++n) dst##8[n] = PG8_LD8(PG8_SB(b, h) + boff + n * 2048); } else { \
        _Pragma("unroll") for (int n = 0; n < 2; ++n) _Pragma("unroll") for (int k = 0; k < 2; ++k) dst[n][k] = *(const LAS bf16x8*)(lds + PG8_SB(b, h) + boff + n * 2048 + k * 1024); } } while (0)
#define PG8_CAT(x, y) __builtin_shufflevector(__builtin_bit_cast(v4i, x), __builtin_bit_cast(v4i, y), 0, 1, 2, 3, 4, 5, 6, 7)
#define PG8_MMA(ai, bj, At, Bt) do { __builtin_amdgcn_s_setprio(1); _Pragma("unroll") for (int m = 0; m < 4; ++m) _Pragma("unroll") for (int n = 0; n < 2; ++n) { \
        if constexpr (FP8) asm volatile("v_mfma_f32_16x16x128_f8f6f4 %0, %1, %2, %0" : "+v"(acc[ai][bj][m][n]) : "v"(Bt##8[n]), "v"(At##8[m])); \
        else { _Pragma("unroll") for (int k = 0; k < 2; ++k) acc[ai][bj][m][n] = __builtin_amdgcn_mfma_f32_16x16x32_bf16(Bt[n][k], At[m][k], acc[ai][bj][m][n], 0, 0, 0); } } __builtin_amdgcn_s_setprio(0); } while (0)
#define PG8_WAIT_V(n) asm volatile("s_waitcnt vmcnt(" #n ")" ::: "memory")
#define PG8_WAIT_L(n) asm volatile("s_waitcnt lgkmcnt(" #n ")" ::: "memory")
#define PG8_BAR __builtin_amdgcn_s_barrier()
#define PG8_SCHED __builtin_amdgcn_sched_barrier(0)
    Unit cur, nxt; int ui = 0;
    if (!S.next(0, cur)) return;
    f32x4 acc[2][2][4][2];
#pragma unroll
    for (int a = 0; a < 2; ++a)
#pragma unroll
        for (int b = 0; b < 2; ++b)
#pragma unroll
            for (int m = 0; m < 4; ++m)
#pragma unroll
                for (int n = 0; n < 2; ++n) acc[a][b][m][n] = (f32x4){0.f, 0.f, 0.f, 0.f};
    bf16x8 At[4][2], B0[2][2], B1[2][2];
    v8i At8[4], B08[2], B18[2];
    const char* cA = (const char*)g.A + (size_t)cur.pm * tstepA + (size_t)cur.sub * g.subA; const char* cB = (const char*)g.Bt + (size_t)cur.pn * tstepB + (size_t)cur.sub * g.subB;
    PG8_STAGE(PG8_SB(0, 0), cB, voffB); PG8_STAGE(PG8_SB(0, 1), cB + hstepB, voffB); PG8_STAGE(PG8_SA(0, 0), cA, voffA); PG8_STAGE(PG8_SA(0, 1), cA + hstepA, voffA);
    if (wr == 1) PG8_BAR;
    PG8_WAIT_V(2); PG8_BAR;
    PG8_STAGE(PG8_SB(1, 0), cB + kstep, voffB); PG8_STAGE(PG8_SA(1, 0), cA + kstep, voffA); PG8_STAGE(PG8_SB(1, 1), cB + hstepB + kstep, voffB);
    PG8_WAIT_V(6); PG8_BAR;
    for (;;) {
        const bool has_next = S.next(ui + 1, nxt);
        const char* nA = has_next ? (const char*)g.A + (size_t)nxt.pm * tstepA + (size_t)nxt.sub * g.subA : cA;
        const char* nB = has_next ? (const char*)g.Bt + (size_t)nxt.pn * tstepB + (size_t)nxt.sub * g.subB : cB;
        for (int t = 0; t < nt; t += 2) {
            const bool last = (t == nt - 2);
            const char* a1 = cA + (size_t)(t + 1) * kstep;
            const char* a2 = last ? nA : cA + (size_t)(t + 2) * kstep; const char* b2 = last ? nB : cB + (size_t)(t + 2) * kstep;
            const char* a3 = a2 + kstep; const char* b3 = b2 + kstep;
            PG8_LDB(B0, 0, 0); PG8_LDB(B1, 0, 1); PG8_SCHED; PG8_LDA(At, 0, 0); PG8_STAGE(PG8_SA(1, 1), a1 + hstepA, voffA);
            PG8_WAIT_V(8); PG8_WAIT_L(0); PG8_BAR; PG8_MMA(0, 0, At, B0); PG8_MMA(0, 1, At, B1); PG8_BAR; PG8_SCHED;
            PG8_LDA(At, 0, 1); PG8_STAGE(PG8_SB(0, 0), b2, voffB); PG8_STAGE(PG8_SB(0, 1), b2 + hstepB, voffB); PG8_STAGE(PG8_SA(0, 0), a2, voffA);
            PG8_WAIT_V(8); PG8_WAIT_L(0); PG8_BAR; PG8_MMA(1, 0, At, B0); PG8_MMA(1, 1, At, B1); PG8_BAR; PG8_SCHED;
            PG8_LDB(B0, 1, 0); PG8_LDB(B1, 1, 1); PG8_SCHED; PG8_LDA(At, 1, 0); PG8_STAGE(PG8_SA(0, 1), a2 + hstepA, voffA);
            PG8_WAIT_V(8); PG8_WAIT_L(0); PG8_BAR; PG8_MMA(0, 0, At, B0); PG8_MMA(0, 1, At, B1); PG8_BAR; PG8_SCHED;
            PG8_LDA(At, 1, 1); PG8_STAGE(PG8_SB(1, 0), b3, voffB); PG8_STAGE(PG8_SB(1, 1), b3 + hstepB, voffB); PG8_STAGE(PG8_SA(1, 0), a3, voffA);
            PG8_WAIT_V(8); PG8_WAIT_L(0); PG8_BAR; PG8_MMA(1, 0, At, B0); PG8_MMA(1, 1, At, B1); PG8_BAR; PG8_SCHED;
        }
        if constexpr (ALIGN_EPI) { if (wr == 0) PG8_BAR; }
        if constexpr (FP8) asm volatile("s_nop 15\n\ts_nop 15" ::: "memory");
        E(acc, cur, wr, wc, fr, fq);
        if (!has_next) break;
        if (!(Epi::CHAIN && nxt.sub != 0)) {
#pragma unroll
        for (int a = 0; a < 2; ++a)
#pragma unroll
            for (int b = 0; b < 2; ++b)
#pragma unroll
                for (int m = 0; m < 4; ++m)
#pragma unroll
                    for (int n = 0; n < 2; ++n) acc[a][b][m][n] = (f32x4){0.f, 0.f, 0.f, 0.f};
        }
        cur = nxt; cA = nA; cB = nB; ++ui;
        if constexpr (ALIGN_EPI) { if (wr == 1) PG8_BAR; }
    }
    PG8_WAIT_V(0);
    if constexpr (!ALIGN_EPI) { if (wr == 0) PG8_BAR; }
    PG8_BAR;
#undef PG8_SA
#undef PG8_SB
#undef PG8_STAGE
#undef PG8_LDA
#undef PG8_LD8
#undef PG8_LDB
#undef PG8_MMA
#undef PG8_CAT
#undef PG8_WAIT_V
#undef PG8_WAIT_L
#undef PG8_BAR
#undef PG8_SCHED
}

struct EpiBf16 {
    static constexpr bool PERM = true, CHAIN = false;
    bf16_t* O; int ldc; const float* rs; int sig_pn; float oscale;
    __device__ __forceinline__ void operator()(f32x4 (&acc)[2][2][4][2], const Unit& u, int wr, int wc, int fr, int fq) const {
        const int row0 = u.pm * BM + wr * 64 + fr, col0 = u.pn * BM + wc * 32 + 8 * fq;
        const bool sg = u.pn >= sig_pn;
#pragma unroll
        for (int ai = 0; ai < 2; ++ai) {
            float rf4[4] = {1.f, 1.f, 1.f, 1.f};
            if (rs) {
#pragma unroll
                for (int m = 0; m < 4; ++m) rf4[m] = rs[row0 + ai * HALF + m * 16]; }
#pragma unroll
            for (int m = 0; m < 4; ++m) { const int row = row0 + ai * HALF + m * 16; bf16_t* rowp = O + (size_t)row * ldc + col0;
                const float r = rf4[m] * oscale;
#pragma unroll
                for (int bj = 0; bj < 2; ++bj) { f32x4 v0 = acc[ai][bj][m][0] * r, v1 = acc[ai][bj][m][1] * r;
                    if (sg) {
#pragma unroll
                        for (int q = 0; q < 4; ++q) { v0[q] = __builtin_amdgcn_rcpf(1.f + __expf(-v0[q])); v1[q] = __builtin_amdgcn_rcpf(1.f + __expf(-v1[q])); } }
                    u32x4 w; w.x = pk2(v0[0], v0[1]); w.y = pk2(v0[2], v0[3]); w.z = pk2(v1[0], v1[1]); w.w = pk2(v1[2], v1[3]);
                    *(u32x4*)(rowp + bj * HALF) = w; } }
        }
    }
};
struct EpiGate8 {
    static constexpr bool PERM = true, CHAIN = false;
    unsigned char* O; size_t ldb; const float* rs; float oscale;
    __device__ __forceinline__ void operator()(f32x4 (&acc)[2][2][4][2], const Unit& u, int wr, int wc, int fr, int fq) const {
        const int row0 = u.pm * BM + wr * 64 + fr, col0 = u.pn * BM + wc * 32 + 8 * fq;
#pragma unroll
        for (int ai = 0; ai < 2; ++ai) {
            float rf4[4];
#pragma unroll
            for (int m = 0; m < 4; ++m) rf4[m] = rs[row0 + ai * HALF + m * 16];
#pragma unroll
            for (int m = 0; m < 4; ++m) { const int row = row0 + ai * HALF + m * 16; unsigned char* rowp = O + (size_t)row * ldb + col0;
                const float r = rf4[m] * oscale;
#pragma unroll
                for (int bj = 0; bj < 2; ++bj) { const f32x4 v0 = acc[ai][bj][m][0] * r, v1 = acc[ai][bj][m][1] * r;
                    unsigned w0 = 0u, w1 = 0u;
#pragma unroll
                    for (int q = 0; q < 4; ++q) {
                        const float s0 = fmaxf(255.f * __builtin_amdgcn_rcpf(1.f + __expf(-v0[q])), 1.f), s1 = fmaxf(255.f * __builtin_amdgcn_rcpf(1.f + __expf(-v1[q])), 1.f);
                        w0 = __builtin_amdgcn_cvt_pk_u8_f32(s0, q, w0); w1 = __builtin_amdgcn_cvt_pk_u8_f32(s1, q, w1); }
                    *(u32x2*)(rowp + bj * HALF) = (u32x2){w0, w1}; } }
        }
    }
};
struct EpiResid {
    static constexpr bool PERM = true, CHAIN = false;
    bf16_t* XB; int ldc; float* RS; unsigned char* XB8;
    __device__ __forceinline__ void operator()(f32x4 (&acc)[2][2][4][2], const Unit& u, int wr, int wc, int fr, int fq) const {
        const int row0 = u.pm * BM + wr * 64 + fr, col0 = u.pn * BM + wc * 32 + 8 * fq;
#pragma unroll
        for (int ai = 0; ai < 2; ++ai) {
            u32x4 xv[4][2];
#pragma unroll
            for (int m = 0; m < 4; ++m)
#pragma unroll
                for (int bj = 0; bj < 2; ++bj) xv[m][bj] = *(const u32x4*)(XB + (size_t)(row0 + ai * HALF + m * 16) * ldc + col0 + bj * HALF);
#pragma unroll
            for (int m = 0; m < 4; ++m) { const int row = row0 + ai * HALF + m * 16; float ss = 0.f;
#pragma unroll
                for (int bj = 0; bj < 2; ++bj) { const u32x4 x = xv[m][bj];
                    const f32x4 y0 = acc[ai][bj][m][0] + (f32x4){lo_bf(x.x), hi_bf(x.x), lo_bf(x.y), hi_bf(x.y)}, y1 = acc[ai][bj][m][1] + (f32x4){lo_bf(x.z), hi_bf(x.z), lo_bf(x.w), hi_bf(x.w)};
                    { u32x4 w; w.x = pk2(y0[0], y0[1]); w.y = pk2(y0[2], y0[3]); w.z = pk2(y1[0], y1[1]); w.w = pk2(y1[2], y1[3]); *(u32x4*)(XB + (size_t)row * ldc + col0 + bj * HALF) = w; }
                    if (XB8) { u32x2 w8; w8.x = pk4_fp8(y0[0], y0[1], y0[2], y0[3]); w8.y = pk4_fp8(y1[0], y1[1], y1[2], y1[3]); *(u32x2*)(XB8 + (size_t)row * ldc + col0 + bj * HALF) = w8; }
                    ss += ((y0[0] * y0[0] + y0[1] * y0[1]) + (y0[2] * y0[2] + y0[3] * y0[3])) + ((y1[0] * y1[0] + y1[1] * y1[1]) + (y1[2] * y1[2] + y1[3] * y1[3])); }
                if (RS) { ss += __shfl_xor(ss, 16); ss += __shfl_xor(ss, 32); if (fq == 0) RS[(size_t)row * 32 + u.pn * 4 + wc] = ss; } }
        }
    }
};
struct EpiUp {
    static constexpr bool PERM = true, CHAIN = false;
    bf16_t* O; const bf16_t* G; const float* cw; const float* cb; const float* rs;
    __device__ __forceinline__ void operator()(f32x4 (&acc)[2][2][4][2], const Unit& u, int wr, int wc, int fr, int fq) const {
        const int row0 = u.pm * BM + wr * 64 + fr, col0 = u.pn * BM + wc * 32 + 8 * fq;
#pragma unroll
        for (int bj = 0; bj < 2; ++bj) {
            const int col = col0 + bj * HALF;
            float w0[8], w1[8], w2[8], bb[8];
#pragma unroll
            for (int e = 0; e < 8; e += 4) { const f32x4 a = *(const f32x4*)(cw + col + e), b = *(const f32x4*)(cw + FF + col + e), c = *(const f32x4*)(cw + 2 * FF + col + e), d = *(const f32x4*)(cb + col + e);
#pragma unroll
                for (int q = 0; q < 4; ++q) { w0[e + q] = a[q]; w1[e + q] = b[q]; w2[e + q] = c[q]; bb[e + q] = d[q]; } }
#pragma unroll
            for (int ai = 0; ai < 2; ++ai) {
                u32x4 g[5]; float rfm[4];
                const int gbase = row0 - fr + ai * HALF;
                const int hb = (gbase & (SEQ - 1)) == 0 ? 0 : (fr >= 14 ? 16 - fr : 1);
                g[4] = *(const u32x4*)(G + (size_t)(gbase - hb) * FF + col);
#pragma unroll
                for (int m = 0; m < 4; ++m) { rfm[m] = rs[row0 + ai * HALF + m * 16]; g[m] = *(const u32x4*)(G + (size_t)(row0 + ai * HALF + m * 16) * FF + col); }
#pragma unroll
                for (int m = 0; m < 4; ++m) {
                    const int row = row0 + ai * HALF + m * 16, t = row & (SEQ - 1);
                    const u32x4 cur = g[m], prv = g[m == 0 ? 4 : m - 1];
                    u32x4 h1, h0;
#pragma unroll
                    for (int q = 0; q < 4; ++q) {
                        const int s1 = __builtin_amdgcn_update_dpp(0, (int)cur[q], 0x111, 0xf, 0xf, false), r1 = __builtin_amdgcn_update_dpp(0, (int)prv[q], 0x121, 0xf, 0xf, false);
                        const int s2 = __builtin_amdgcn_update_dpp(0, (int)cur[q], 0x112, 0xf, 0xf, false), r2 = __builtin_amdgcn_update_dpp(0, (int)prv[q], 0x122, 0xf, 0xf, false);
                        h1[q] = t < 1 ? 0u : (unsigned)(fr < 1 ? r1 : s1); h0[q] = t < 2 ? 0u : (unsigned)(fr < 2 ? r2 : s2); }
                    float r[8];
#pragma unroll
                    for (int q = 0; q < 4; ++q) {
                        const float c0 = w0[2 * q] * lo_bf(h0[q]) + w1[2 * q] * lo_bf(h1[q]) + w2[2 * q] * lo_bf(cur[q]) + bb[2 * q];
                        const float c1 = w0[2 * q + 1] * hi_bf(h0[q]) + w1[2 * q + 1] * hi_bf(h1[q]) + w2[2 * q + 1] * hi_bf(cur[q]) + bb[2 * q + 1];
                        r[2 * q] = siluf_(c0); r[2 * q + 1] = siluf_(c1);
                    }
                    const float rn = rfm[m];
                    const f32x4 v0 = acc[ai][bj][m][0] * rn, v1 = acc[ai][bj][m][1] * rn;
                    u32x4 w; w.x = pk2(r[0] * v0[0], r[1] * v0[1]); w.y = pk2(r[2] * v0[2], r[3] * v0[3]); w.z = pk2(r[4] * v1[0], r[5] * v1[1]); w.w = pk2(r[6] * v1[2], r[7] * v1[3]);
                    *(u32x4*)(O + (size_t)row * FF + col) = w;
                }
            }
        }
    }
};
struct EpiMerge {
    static constexpr bool PERM = true, CHAIN = true;
    bf16_t* O; const bf16_t* P;
    __device__ __forceinline__ void operator()(f32x4 (&acc)[2][2][4][2], const Unit& u, int wr, int wc, int fr, int fq) const {
        const int row0 = u.pm * BM + wr * 64 + fr, col0 = u.pn * BM + wc * 32 + 8 * fq, n = u.sub;
#pragma unroll
        for (int ai = 0; ai < 2; ++ai) { constexpr int mb = 0;
            u32x2 ga[4][2], gb[4][2];
#pragma unroll
            for (int m = mb; m < mb + 4; ++m)
#pragma unroll
                for (int bj = 0; bj < 2; ++bj) {
                    const unsigned char* gp = (const unsigned char*)(P + (size_t)(row0 + ai * HALF + m * 16) * NP + C_GATE) + n * D + col0 + bj * HALF;
                    ga[m][bj] = *(const u32x2*)gp; gb[m][bj] = *(const u32x2*)(gp + (n < 3 ? D : 0)); }
#pragma unroll
            for (int m = mb; m < mb + 4; ++m) {
                const int row = row0 + ai * HALF + m * 16;
#pragma unroll
                for (int bj = 0; bj < 2; ++bj) {
                    const int col = col0 + bj * HALF;
                    float f[8];
#pragma unroll
                    for (int q = 0; q < 2; ++q) {
                        const unsigned a = ga[m][bj][q], b = gb[m][bj][q];
                        const float a0 = (float)(a & 255u), a1 = (float)((a >> 8) & 255u), a2 = (float)((a >> 16) & 255u), a3 = (float)(a >> 24);
                        if (n < 3) {
                            f[4 * q] = a0 * __builtin_amdgcn_rcpf((float)(b & 255u)); f[4 * q + 1] = a1 * __builtin_amdgcn_rcpf((float)((b >> 8) & 255u));
                            f[4 * q + 2] = a2 * __builtin_amdgcn_rcpf((float)((b >> 16) & 255u)); f[4 * q + 3] = a3 * __builtin_amdgcn_rcpf((float)(b >> 24));
                        } else { f[4 * q] = a0 * (1.f / 255.f); f[4 * q + 1] = a1 * (1.f / 255.f); f[4 * q + 2] = a2 * (1.f / 255.f); f[4 * q + 3] = a3 * (1.f / 255.f); }
                    }
                    f32x4 v0 = acc[ai][bj][m][0], v1 = acc[ai][bj][m][1];
                    v0[0] *= f[0]; v0[1] *= f[1]; v0[2] *= f[2]; v0[3] *= f[3]; v1[0] *= f[4]; v1[1] *= f[5]; v1[2] *= f[6]; v1[3] *= f[7];
                    if (n < 3) { acc[ai][bj][m][0] = v0; acc[ai][bj][m][1] = v1; }
                    else { u32x4 w; w.x = pk2(v0[0], v0[1]); w.y = pk2(v0[2], v0[3]); w.z = pk2(v1[0], v1[1]); w.w = pk2(v1[2], v1[3]);
                        *(u32x4*)(O + (size_t)row * D + col) = w; }
                }
            }
        }
    }
};
}
struct Params { const float* in[21]; float* out; unsigned char* ws; int ph_lo, ph_hi; };
enum { IN_X = 0, IN_NORM_MIX, IN_W_IN, IN_CQ_NORM, IN_W_UQ, IN_W_QIDX, IN_FOX_BIAS, IN_GDN_CONV, IN_GDN_ALOG, IN_GDN_DT, IN_GDN_NORM, IN_W_BRANCH, IN_W_OUT, IN_REL_BIAS,
       IN_NORM_FFN, IN_W_GATE, IN_W_UP, IN_FFN_CONV, IN_FFN_CONVB, IN_W_DOWN, IN_FINAL_NORM };
struct Ctx {
    LAS unsigned char* lds; volatile LAS unsigned* misc; unsigned* ctl; unsigned char* ws;
    int tid, lane, wave, G, bid;
    const LAS unsigned long long* inl; float* out;
};
#define INP(i) ((const float*)c.inl[(i)])
#define WSP(T, off) ((T*)(c.ws + (off)))

DI int q_next(const Ctx& c, int qid) {
    __syncthreads();
    if (c.tid == 0) c.misc[0] = __hip_atomic_fetch_add(c.ctl + CW_Q + 64 * qid, 1u, __ATOMIC_RELAXED, __HIP_MEMORY_SCOPE_AGENT);
    __syncthreads();
    return (int)c.misc[0];
}

template <bool MAP>
DI void cvt_item(const float* W, int K, int N, bf16_t* WT, int nblk, const float* kscale, LAS float*  , int item, int lane) {
    const int kb = item / nblk, nb = item % nblk, k0 = 64 * kb, n0 = 64 * nb;
    const int n = n0 + lane; const int sc = MAP ? src_col(n) : n;
    const int scc = sc >= 0 ? sc : 0; const float live = sc >= 0 ? 1.f : 0.f;
    const float* src = W + (size_t)k0 * N + scc;
    float v[64];
#pragma unroll
    for (int i = 0; i < 64; ++i) v[i] = src[(size_t)i * N];
    if (kscale) {
#pragma unroll
        for (int i = 0; i < 64; ++i) v[i] *= kscale[k0 + i]; }
    bf16_t* dst = WT + (size_t)n * K + k0;
#pragma unroll
    for (int q = 0; q < 8; ++q) { u32x4 o; o.x = pk2(v[8 * q] * live, v[8 * q + 1] * live); o.y = pk2(v[8 * q + 2] * live, v[8 * q + 3] * live); o.z = pk2(v[8 * q + 4] * live, v[8 * q + 5] * live); o.w = pk2(v[8 * q + 6] * live, v[8 * q + 7] * live);
        *(u32x4*)(dst + 8 * q) = o; }
}
DI void cvt_item_gate8(const float* W, const float* gain, unsigned char* W8, int item, int lane) {
    constexpr int nblk = 8192 / 64; const int kb = item / nblk, nb = item % nblk, k0 = 64 * kb, n = 64 * nb + lane;
    const float* src = W + (size_t)k0 * NSRC + (6364 + n);
    float v[64];
#pragma unroll
    for (int i = 0; i < 64; ++i) v[i] = src[(size_t)i * NSRC];
#pragma unroll
    for (int i = 0; i < 64; ++i) v[i] *= gain[k0 + i] * 128.f;
    unsigned char* dst = W8 + (size_t)n * D + k0;
#pragma unroll
    for (int q = 0; q < 4; ++q) { u32x4 o; o.x = pk4_fp8(v[16 * q], v[16 * q + 1], v[16 * q + 2], v[16 * q + 3]); o.y = pk4_fp8(v[16 * q + 4], v[16 * q + 5], v[16 * q + 6], v[16 * q + 7]);
        o.z = pk4_fp8(v[16 * q + 8], v[16 * q + 9], v[16 * q + 10], v[16 * q + 11]); o.w = pk4_fp8(v[16 * q + 12], v[16 * q + 13], v[16 * q + 14], v[16 * q + 15]); *(u32x4*)(dst + 16 * q) = o; }
}
constexpr int CI_INB = (D / 64) * (C_GATE / 64), CI_ING = (D / 64) * (8192 / 64), CI_IN = CI_INB + CI_ING, CI_BR = (512 / 64) * (D / 64), CI_OUT = (D / 64) * (D / 64), CI_UQ = (384 / 64) * (512 / 64), CI_QI = (384 / 64) * (1024 / 64);
constexpr int CI_G = (D / 64) * (FF / 64), CI_D = (FF / 64) * (D / 64);
constexpr int CI_FFN = 2 * CI_G + CI_D, CI_EARLY_MIX = CI_IN + CI_UQ + CI_QI, CI_LATE = 4 * CI_BR + CI_OUT;
DI void cvt_ffn_item(const Ctx& c, int l, int r, LAS float* scr) {
    const float* wg = INP(IN_W_GATE) + (size_t)l * D * FF; const float* wu = INP(IN_W_UP) + (size_t)l * D * FF; const float* wd = INP(IN_W_DOWN) + (size_t)l * FF * D;
    const float* gf = INP(IN_NORM_FFN) + (size_t)l * D;
    if (r < CI_G) { cvt_item<false>(wg, D, FF, WSP(bf16_t, WS_WG), FF / 64, gf, scr, r, c.lane); return; } r -= CI_G;
    if (r < CI_G) { cvt_item<false>(wu, D, FF, WSP(bf16_t, WS_WU), FF / 64, gf, scr, r, c.lane); return; } r -= CI_G;
    cvt_item<false>(wd, FF, D, WSP(bf16_t, WS_WD), D / 64, nullptr, scr, r, c.lane);
}
DI void cvt_early_mix_item(const Ctx& c, int l, int r, LAS float* scr) {
    const float* w_in = INP(IN_W_IN) + (size_t)l * D * NSRC; const float* w_uq = INP(IN_W_UQ) + (size_t)l * 384 * 512; const float* w_qi = INP(IN_W_QIDX) + (size_t)l * 384 * 1024;
    const float* cqg = INP(IN_CQ_NORM) + (size_t)l * 384;
    if (r < CI_INB) { cvt_item<true>(w_in, D, NSRC, WSP(bf16_t, WS_WIN), C_GATE / 64, INP(IN_NORM_MIX) + (size_t)l * D, scr, r, c.lane); return; } r -= CI_INB;
    if (r < CI_ING) { cvt_item_gate8(w_in, INP(IN_NORM_MIX) + (size_t)l * D, WSP(unsigned char, WS_WG8), r, c.lane); return; } r -= CI_ING;
    if (r < CI_UQ) { cvt_item<false>(w_uq, 384, 512, WSP(bf16_t, WS_WDSA), 512 / 64, cqg, scr, r, c.lane); return; } r -= CI_UQ;
    cvt_item<false>(w_qi, 384, 1024, WSP(bf16_t, WS_WDSA) + (size_t)512 * 384, 1024 / 64, cqg, scr, r, c.lane);
}
DI void cvt_late_item(const Ctx& c, int l, int r, LAS float* scr) {
    const float* w_br = INP(IN_W_BRANCH) + (size_t)l * 4 * 512 * D; const float* w_out = INP(IN_W_OUT) + (size_t)l * D * D;
    if (r < 4 * CI_BR) { const int n = r / CI_BR; cvt_item<false>(w_br + (size_t)n * 512 * D, 512, D, WSP(bf16_t, WS_WBR) + (size_t)n * D * 512, D / 64, nullptr, scr, r % CI_BR, c.lane); return; } r -= 4 * CI_BR;
    cvt_item<false>(w_out, D, D, WSP(bf16_t, WS_WOUT), D / 64, nullptr, scr, r, c.lane);
}
DI int cvt_early_nblk(int l) { return (CI_FFN + (l + 1 < DEPTH ? CI_EARLY_MIX : 0) + 31) / 32; }
DI void cvt_early_block(const Ctx& c, int l, int blk) {
    LAS float* scr = (LAS float*)(c.lds + c.wave * 16384);
    const int tot = CI_FFN + (l + 1 < DEPTH ? CI_EARLY_MIX : 0);
    __syncthreads();
    for (int k = 0; k < 4; ++k) { const int it = blk * 32 + c.wave * 4 + k; if (it >= tot) break;
        if (it < CI_FFN) cvt_ffn_item(c, l, it, scr); else cvt_early_mix_item(c, l + 1, it - CI_FFN, scr); }
    __syncthreads();
}
DI void cvt_late_all(const Ctx& c, int l) {
    LAS float* scr = (LAS float*)(c.lds + c.wave * 16384);
    const int gw = c.bid * 8 + c.wave, NGW = c.G * 8;
    for (int it = gw; it < CI_LATE; it += NGW) cvt_late_item(c, l, it, scr);
}
DI void cvt_mixer0(const Ctx& c) {
    LAS float* scr = (LAS float*)(c.lds + c.wave * 16384);
    const int gw = c.bid * 8 + c.wave, NGW = c.G * 8;
    for (int it = gw; it < CI_EARLY_MIX + CI_LATE; it += NGW) { if (it < CI_EARLY_MIX) cvt_early_mix_item(c, 0, it, scr); else cvt_late_item(c, 0, it - CI_EARLY_MIX, scr); }
}
DI void make_tables(const Ctx& c) {
    float* cs = WSP(float, WS_ROPE); float* sn = cs + SEQ * 64;
    for (int e = c.bid * 512 + c.tid; e < SEQ * 64; e += c.G * 512) {
        const int pos = e >> 6, i = e & 63;
        const float inv = 1.f / exp2f((float)i * (13.287712379549449f / 64.f));
        const float ang = (float)pos * inv;
        cs[e] = cosf(ang); sn[e] = sinf(ang);
    }
    if (c.bid == 0) {
        float* bt = WSP(float, WS_BT); const float* rb = INP(IN_REL_BIAS);
        for (int e = c.tid; e < 4 * 128 + 4; e += 512) {
            int h, rel; if (e < 512) { h = e >> 7; rel = e & 127; } else { h = e - 512; rel = 128; }
            int bk;
            if (rel < 16) bk = rel; else { const float lf = logf((float)rel / 16.f) / 2.0794415416798357f * 16.f; bk = 16 + (int)lf; if (bk > 31) bk = 31; }
            bt[e] = rb[bk * 4 + h];
        }
    }
}

DI void rmsnorm_rows(const Ctx& c, const float* x, const float* gain, bf16_t* dst, float* copy) {
    const int gw = c.bid * 8 + c.wave, NGW = c.G * 8;
    f32x4 gv[8];
#pragma unroll
    for (int j = 0; j < 8; ++j) gv[j] = *((const f32x4*)gain + c.lane + 64 * j);
    for (int m = gw; m < M; m += NGW) {
        const f32x4* xr = (const f32x4*)(x + (size_t)m * D) + c.lane;
        f32x4 v[8]; float s = 0.f;
#pragma unroll
        for (int j = 0; j < 8; ++j) { v[j] = xr[64 * j]; s += (v[j].x * v[j].x + v[j].y * v[j].y) + (v[j].z * v[j].z + v[j].w * v[j].w); }
        const float r = rsqrtf(wave_sum(s) * (1.f / D) + EPS);
        u32x2* o = (u32x2*)(dst + (size_t)m * D) + c.lane;
#pragma unroll
        for (int j = 0; j < 8; ++j) { u32x2 w; w.x = pk2(v[j].x * r * gv[j].x, v[j].y * r * gv[j].y); w.y = pk2(v[j].z * r * gv[j].z, v[j].w * r * gv[j].w); o[64 * j] = w; }
        if (copy) { f32x4* cp = (f32x4*)(copy + (size_t)m * D) + c.lane;
#pragma unroll
            for (int j = 0; j < 8; ++j) cp[64 * j] = v[j]; }
    }
}
DI void x0_rows(const Ctx& c, const float* x, bf16_t* xb, float* rs, unsigned char* xb8) {
    const int gw = c.bid * 8 + c.wave, NGW = c.G * 8;
    for (int m = gw; m < M; m += NGW) {
        const f32x4* xr = (const f32x4*)(x + (size_t)m * D) + c.lane;
        f32x4 v[8]; float s = 0.f;
#pragma unroll
        for (int j = 0; j < 8; ++j) { v[j] = xr[64 * j]; s += (v[j].x * v[j].x + v[j].y * v[j].y) + (v[j].z * v[j].z + v[j].w * v[j].w); }
        s = wave_sum(s); if (c.lane < 32) rs[(size_t)m * 32 + c.lane] = c.lane == 0 ? s : 0.f;
        u32x2* o = (u32x2*)(xb + (size_t)m * D) + c.lane;
#pragma unroll
        for (int j = 0; j < 8; ++j) { u32x2 w; w.x = pk2(v[j].x, v[j].y); w.y = pk2(v[j].z, v[j].w); o[64 * j] = w;
            ((unsigned*)(xb8 + (size_t)m * D))[c.lane + 64 * j] = pk4_fp8(v[j].x, v[j].y, v[j].z, v[j].w); }
    }
}
DI void row_factors(const Ctx& c, const float* rsp, float* rf) {
    for (int row = c.bid * 512 + c.tid; row < M; row += c.G * 512) {
        const f32x4* p = (const f32x4*)(rsp + (size_t)row * 32); float s = 0.f;
#pragma unroll
        for (int q = 0; q < 8; ++q) { const f32x4 v = p[q]; s += (v[0] + v[1]) + (v[2] + v[3]); }
        rf[row] = rsqrtf(s * (1.f / D) + EPS);
    }
}
template <class SchedT>
DI void row_factors_units(const Ctx& c, const float* rsp, float* rf, const SchedT& S, int& last_pm) {
    pg8::Unit u;
    for (int i = 0; S.next(i, u); ++i) {
        if (u.pm == last_pm) continue;
        last_pm = u.pm;
        const int row = u.pm * 256 + (c.tid >> 1);
        const f32x4* p = (const f32x4*)(rsp + (size_t)row * 32 + 16 * (c.tid & 1)); float s = 0.f;
#pragma unroll
        for (int q = 0; q < 4; ++q) { const f32x4 v = p[q]; s += (v[0] + v[1]) + (v[2] + v[3]); }
        s += __shfl_xor(s, 1);
        if (!(c.tid & 1)) rf[row] = rsqrtf(s * (1.f / D) + EPS);
    }
    __syncthreads();
}
DI void final_norm(const Ctx& c, float* x, const float* gain, const float fac = 1.f) {
    const int gw = c.bid * 8 + c.wave, NGW = c.G * 8;
    f32x4 gv[8];
#pragma unroll
    for (int j = 0; j < 8; ++j) gv[j] = *((const f32x4*)gain + c.lane + 64 * j);
    for (int m = gw; m < M; m += NGW) {
        f32x4* xr = (f32x4*)(x + (size_t)m * D) + c.lane;
        f32x4 v[8]; float s = 0.f;
#pragma unroll
        for (int j = 0; j < 8; ++j) { v[j] = xr[64 * j]; s += (v[j].x * v[j].x + v[j].y * v[j].y) + (v[j].z * v[j].z + v[j].w * v[j].w); }
        const float r = rsqrtf(wave_sum(s) * (1.f / D) + EPS) * fac;
#pragma unroll
        for (int j = 0; j < 8; ++j) xr[64 * j] = v[j] * r * gv[j];
    }
}
DI void final_norm_bf(const Ctx& c, const bf16_t* xb, float* out, const float* gain) {
    const int gw = c.bid * 8 + c.wave, NGW = c.G * 8;
    f32x4 gv[8];
#pragma unroll
    for (int j = 0; j < 8; ++j) gv[j] = *((const f32x4*)gain + c.lane + 64 * j);
    for (int m = gw; m < M; m += NGW) {
        const u32x2* xr = (const u32x2*)(xb + (size_t)m * D) + c.lane;
        f32x4 v[8]; float s = 0.f;
#pragma unroll
        for (int j = 0; j < 8; ++j) { const u32x2 w = xr[64 * j]; v[j] = (f32x4){lo_bf(w.x), hi_bf(w.x), lo_bf(w.y), hi_bf(w.y)}; s += (v[j].x * v[j].x + v[j].y * v[j].y) + (v[j].z * v[j].z + v[j].w * v[j].w); }
        const float r = rsqrtf(wave_sum(s) * (1.f / D) + EPS);
        f32x4* o = (f32x4*)(out + (size_t)m * D) + c.lane;
#pragma unroll
        for (int j = 0; j < 8; ++j) o[64 * j] = v[j] * r * gv[j];
    }
}

DI void prep_tokens(const Ctx& c, int item) {
    const int row0 = item * 64, b = row0 / SEQ, s0 = row0 % SEQ;
    const bf16_t* P = WSP(bf16_t, WS_PROJ);
    { const float* cs = WSP(float, WS_ROPE); const float* sn = cs + SEQ * 64; bf16_t* RQ = WSP(bf16_t, WS_RQ); bf16_t* RK = WSP(bf16_t, WS_RK);
#pragma unroll 2
      for (int k = 0; k < 8; ++k) { const int e = c.tid + 512 * k;
        const int i8 = e & 7, head = (e >> 3) & 3, which = (e >> 5) & 1, tok = e >> 6;
        const int row = row0 + tok, pos = s0 + tok;
        const bf16_t* src = P + (size_t)row * NP + (which ? C_RK : C_RQ) + head * 128 + 8 * i8;
        const u32x4 a = *(const u32x4*)src, bq = *(const u32x4*)(src + 64);
        const f32x4 c0 = *(const f32x4*)(cs + pos * 64 + 8 * i8), c1 = *(const f32x4*)(cs + pos * 64 + 8 * i8 + 4), s0v = *(const f32x4*)(sn + pos * 64 + 8 * i8), s1v = *(const f32x4*)(sn + pos * 64 + 8 * i8 + 4);
        float x1[8], x2[8], co[8], si[8];
#pragma unroll
        for (int q = 0; q < 4; ++q) { x1[2 * q] = lo_bf(a[q]); x1[2 * q + 1] = hi_bf(a[q]); x2[2 * q] = lo_bf(bq[q]); x2[2 * q + 1] = hi_bf(bq[q]); co[q] = c0[q]; co[4 + q] = c1[q]; si[q] = s0v[q]; si[4 + q] = s1v[q]; }
        u32x4 o1, o2;
#pragma unroll
        for (int q = 0; q < 4; ++q) { o1[q] = pk2(x1[2 * q] * co[2 * q] - x2[2 * q] * si[2 * q], x1[2 * q + 1] * co[2 * q + 1] - x2[2 * q + 1] * si[2 * q + 1]);
            o2[q] = pk2(x1[2 * q] * si[2 * q] + x2[2 * q] * co[2 * q], x1[2 * q + 1] * si[2 * q + 1] + x2[2 * q + 1] * co[2 * q + 1]); }
        bf16_t* dst = (which ? RK : RQ) + (size_t)row * 512 + head * 128 + 8 * i8;
        *(u32x4*)dst = o1; *(u32x4*)(dst + 64) = o2;
      } }
    { const int tok = c.tid >> 3, part = c.tid & 7;
      const bf16_t* src = P + (size_t)(row0 + tok) * NP + C_DCQ + part * 48; float s = 0.f;
#pragma unroll
      for (int j = 0; j < 6; ++j) { const u32x4 w = *(const u32x4*)(src + 8 * j);
#pragma unroll
          for (int q = 0; q < 4; ++q) { const float a = lo_bf(w[q]), bb = hi_bf(w[q]); s += a * a + bb * bb; } }
      s += __shfl_xor(s, 1); s += __shfl_xor(s, 2); s += __shfl_xor(s, 4);
      if (part == 0) WSP(float, WS_RDSA)[row0 + tok] = rsqrtf(s * (1.f / 384.f) + EPS); }
    LAS bf16_t* tile = (LAS bf16_t*)c.lds;
    bf16_t* VT = WSP(bf16_t, WS_VT);
#pragma unroll
    for (int rd = 0; rd < 2; ++rd) {
        const int nch = rd == 0 ? 5 : 4, ch0 = rd == 0 ? 0 : 5;
        u32x4 w[10];
#pragma unroll
        for (int q = 0; q < 10; ++q) if (q < 2 * nch) { const int chn = ch0 + (q >> 1); const int scol = chn < 4 ? C_RV + 128 * chn : chn < 8 ? C_FV + 128 * (chn - 4) : C_DV;
            const int idx = c.tid + 512 * (q & 1), r = idx >> 4, ch = idx & 15; w[q] = *(const u32x4*)(P + (size_t)(row0 + r) * NP + scol + ch * 8); }
        __syncthreads();
#pragma unroll
        for (int q = 0; q < 10; ++q) if (q < 2 * nch) { const int idx = c.tid + 512 * (q & 1), r = idx >> 4, ch = idx & 15;
            LAS unsigned* d = (LAS unsigned*)(tile + r * 642 + (q >> 1) * 128 + ch * 8); d[0] = w[q].x; d[1] = w[q].y; d[2] = w[q].z; d[3] = w[q].w; }
        __syncthreads();
#pragma unroll
        for (int q = 0; q < 10; ++q) if (q < 2 * nch) { const int chn = ch0 + (q >> 1); const int vrow = chn < 4 ? VT_RET + 128 * chn : chn < 8 ? VT_FOX + 128 * (chn - 4) : VT_DSA;
            const int idx = c.tid + 512 * (q & 1), col = idx >> 3, tg = idx & 7;
            unsigned short v[8];
#pragma unroll
            for (int e = 0; e < 8; ++e) v[e] = tile[(8 * tg + e) * 642 + (q >> 1) * 128 + col];
            u32x4 o; o.x = v[0] | ((unsigned)v[1] << 16); o.y = v[2] | ((unsigned)v[3] << 16); o.z = v[4] | ((unsigned)v[5] << 16); o.w = v[6] | ((unsigned)v[7] << 16);
            *(u32x4*)(VT + ((size_t)(b * VT_ROWS + vrow + col)) * VT_LD + s0 + 8 * tg) = o; }
    }
    __syncthreads();
}
DI void prep_cfox(const Ctx& c, int item, int l) {
    const int b = item >> 2, h = item & 3;
    const bf16_t* P = WSP(bf16_t, WS_PROJ); const float fb = INP(IN_FOX_BIAS)[l * 4 + h];
    float v[8]; float run = 0.f;
#pragma unroll
    for (int j = 0; j < 8; ++j) { const float x = bf2f(P[(size_t)(b * SEQ + c.tid * 8 + j) * NP + C_FF + h]) + fb;
        const float ls = fminf(x, 0.f) - __logf(1.f + __expf(-fabsf(x))); run += ls; v[j] = run; }
    float tot = run;
#pragma unroll
    for (int o = 1; o < 64; o <<= 1) { const float t = __shfl_up(tot, o); if (c.lane >= o) tot += t; }
    LAS float* wt = (LAS float*)c.lds;
    __syncthreads();
    if (c.lane == 63) wt[c.wave] = tot;
    __syncthreads();
    float pre = tot - run;
    for (int w = 0; w < c.wave; ++w) pre += wt[w];
    float* dst = WSP(float, WS_CFOX) + (size_t)(b * 4 + h) * SEQ + c.tid * 8;
#pragma unroll
    for (int j = 0; j < 8; ++j) dst[j] = pre + v[j];
    __syncthreads();
}
DI void gdn_finish(const Ctx& c, int l) {
    const int gw = c.bid * 8 + c.wave, NGW = c.G * 8;
    const float* OG = WSP(float, WS_OG); const bf16_t* P = WSP(bf16_t, WS_PROJ); bf16_t* BR = WSP(bf16_t, WS_BR);
    const float* ng = INP(IN_GDN_NORM) + l * 128 + ((8 * c.lane) & 127);
    const f32x4 g0 = *(const f32x4*)ng, g1 = *(const f32x4*)(ng + 4);
    for (int m = gw; m < M; m += NGW) {
        const f32x4 a = *(const f32x4*)(OG + (size_t)m * 512 + 8 * c.lane), bq = *(const f32x4*)(OG + (size_t)m * 512 + 8 * c.lane + 4);
        float s = (a.x * a.x + a.y * a.y) + (a.z * a.z + a.w * a.w) + (bq.x * bq.x + bq.y * bq.y) + (bq.z * bq.z + bq.w * bq.w);
        s += __shfl_xor(s, 1); s += __shfl_xor(s, 2); s += __shfl_xor(s, 4); s += __shfl_xor(s, 8);
        const float r = rsqrtf(s * (1.f / 128.f) + EPS);
        const u32x4 z = *(const u32x4*)(P + (size_t)m * NP + C_GZ + 8 * c.lane);
        u32x4 w;
        w.x = pk2(a.x * r * g0.x * siluf_(lo_bf(z.x)), a.y * r * g0.y * siluf_(hi_bf(z.x)));
        w.y = pk2(a.z * r * g0.z * siluf_(lo_bf(z.y)), a.w * r * g0.w * siluf_(hi_bf(z.y)));
        w.z = pk2(bq.x * r * g1.x * siluf_(lo_bf(z.z)), bq.y * r * g1.y * siluf_(hi_bf(z.z)));
        w.w = pk2(bq.z * r * g1.z * siluf_(lo_bf(z.w)), bq.w * r * g1.w * siluf_(hi_bf(z.w)));
        *(u32x4*)(BR + (size_t)m * D + O_GDN + 8 * c.lane) = w;
    }
}
enum { AT_FOX = 0, AT_RET = 1, AT_DSA = 2 };
constexpr int AT_KSTR = 272, AT_VSTR = 136;
constexpr int AT_KBYTES = 64 * AT_KSTR, AT_VBYTES = 128 * AT_VSTR;
constexpr int AT_BUF = AT_KBYTES + AT_VBYTES + 256;
constexpr int AT_TAB = 2 * AT_BUF;
constexpr float SM_SCALE = 0.08838834764831845f, LOG2E = 1.4426950408889634f;

template <int MODE>
DI void attn_unit(const Ctx& c, int l, int b, int hh, int q0) {
    LAS unsigned char* lds = c.lds;
    const int tid = c.tid, w = c.wave, lane = c.lane, l31 = lane & 31, hf = lane >> 5;
    const int head = (MODE == AT_DSA) ? (w >> 1) : hh;
    const int qw0 = q0 + ((MODE == AT_DSA) ? 32 * (w & 1) : 32 * w);
    const int t = qw0 + l31;
    constexpr int QR = (MODE == AT_DSA) ? 64 : 256;
    const int nkt = (q0 + QR) / 64;
    const bf16_t* P = WSP(bf16_t, WS_PROJ);
    const bf16_t* Qb; int ldq; const bf16_t* Kb; int ldk; int vrow0, ocol;
    if (MODE == AT_FOX) { Qb = P + C_FQ + head * 128; ldq = NP; Kb = P + C_FK + head * 128; ldk = NP; vrow0 = VT_FOX + head * 128; ocol = O_FOX + head * 128; }
    else if (MODE == AT_RET) { Qb = WSP(bf16_t, WS_RQ) + head * 128; ldq = 512; Kb = WSP(bf16_t, WS_RK) + head * 128; ldk = 512; vrow0 = VT_RET + head * 128; ocol = O_RET + head * 128; }
    else { Qb = WSP(bf16_t, WS_QD) + head * 128; ldq = 1536; Kb = P + C_DK; ldk = NP; vrow0 = VT_DSA; ocol = O_DSA + head * 128; }
    const bf16_t* VTb = WSP(bf16_t, WS_VT) + (size_t)(b * VT_ROWS + vrow0) * VT_LD;
    const float* cf = WSP(float, WS_CFOX) + (size_t)(b * 4 + head) * SEQ;

    bf16x8 qf[8];
    { const bf16_t* qp = Qb + (size_t)(b * SEQ + t) * ldq + 8 * hf;
#pragma unroll
      for (int s = 0; s < 8; ++s) qf[s] = *(const bf16x8*)(qp + 16 * s); }
    float xscale = SM_SCALE * LOG2E, cq = 0.f, lg = 0.f;
    if (MODE == AT_DSA) xscale = SM_SCALE * LOG2E * WSP(float, WS_RDSA)[b * SEQ + t];
    if (MODE == AT_RET) { lg = log2f(1.f - exp2f(-5.f - (float)head)); xscale = SM_SCALE; }
    const unsigned long long* mrow = WSP(unsigned long long, WS_MASK) + (size_t)(b * SEQ + t) * 64;
    LAS float* tab = (LAS float*)(lds + AT_TAB);
    __syncthreads();
    if (MODE == AT_RET) { if (tid < 64) tab[tid] = exp2f(lg * (float)(63 - tid)); }
    if (MODE == AT_DSA) { const float* bt = WSP(float, WS_BT); for (int e = tid; e < 516; e += 512) tab[e] = bt[e] * LOG2E; }

    u32x4 kreg[2], vreg[2]; float creg = 0.f; unsigned long long mreg = 0ull, mcur = 0ull;
    auto issue = [&](int j) {
#pragma unroll
        for (int p = 0; p < 2; ++p) { const int idx = tid + 512 * p;
            kreg[p] = *(const u32x4*)(Kb + (size_t)(b * SEQ + 64 * j + (idx >> 4)) * ldk + (idx & 15) * 8);
            vreg[p] = *(const u32x4*)(VTb + (size_t)(idx >> 3) * VT_LD + 64 * j + (idx & 7) * 8); }
        if (MODE == AT_FOX) creg = cf[64 * j + (tid & 63)];
        if (MODE == AT_DSA) mreg = mrow[j];
    };
    auto commit = [&](int buf) {
        LAS unsigned char* kb = lds + buf * AT_BUF; LAS unsigned char* vb = kb + AT_KBYTES;
#pragma unroll
        for (int p = 0; p < 2; ++p) { const int idx = tid + 512 * p;
            *(LAS u32x4*)(kb + (idx >> 4) * AT_KSTR + (idx & 15) * 16) = kreg[p];
            LAS u32x2* vd = (LAS u32x2*)(vb + (idx >> 3) * AT_VSTR + (idx & 7) * 16);
            vd[0] = (u32x2){vreg[p].x, vreg[p].y}; vd[1] = (u32x2){vreg[p].z, vreg[p].w}; }
        if (MODE == AT_FOX) { if (tid < 64) ((LAS float*)(vb + AT_VBYTES))[tid] = creg * LOG2E; }
        mcur = mreg;
    };
    f32x16 o[4];
#pragma unroll
    for (int i = 0; i < 4; ++i)
#pragma unroll
        for (int r = 0; r < 16; ++r) o[i][r] = 0.f;
    float mrun = -1e30f, lsum = 0.f;

    const int j0 = (MODE == AT_RET) ? q0 / 64 : 0;
    const int cst = q0 + 128 * (w >> 2);
    issue(j0); commit(j0 & 1);
    __syncthreads();
    for (int j = j0; j < nkt; ++j) {
        const unsigned long long mtile = mcur;
        if (j + 1 < nkt) issue(j + 1);
        if (64 * j <= qw0 + 31 && (MODE != AT_RET || 64 * j >= cst)) {
            LAS unsigned char* kb = lds + (j & 1) * AT_BUF; LAS unsigned char* vb = kb + AT_KBYTES;
            f32x16 s0, s1;
#pragma unroll
            for (int r = 0; r < 16; ++r) { s0[r] = 0.f; s1[r] = 0.f; }
            constexpr int KBATCH = (MODE == AT_DSA) ? 2 : 4;
            const LAS unsigned char* kp0 = kb + l31 * AT_KSTR + 16 * hf;
#pragma unroll
            for (int sb = 0; sb < 8; sb += KBATCH) {
                bf16x8 ka[KBATCH], kc[KBATCH];
#pragma unroll
                for (int s = 0; s < KBATCH; ++s) { ka[s] = *(const LAS bf16x8*)(kp0 + 32 * (sb + s)); kc[s] = *(const LAS bf16x8*)(kp0 + 32 * AT_KSTR + 32 * (sb + s)); }
                __builtin_amdgcn_sched_barrier(0);
#pragma unroll
                for (int s = 0; s < KBATCH; ++s) { s0 = MFMA32(ka[s], qf[sb + s], s0); s1 = MFMA32(kc[s], qf[sb + s], s1); }
                __builtin_amdgcn_sched_barrier(0);
            }
            const LAS unsigned char* vp0 = vb + l31 * AT_VSTR + 8 * hf;
            bf16x8 va[8];
            if (MODE != AT_DSA) {
#pragma unroll
            for (int dt = 0; dt < 2; ++dt)
#pragma unroll
                for (int ks = 0; ks < 4; ++ks) { const LAS unsigned char* vp = vp0 + 32 * dt * AT_VSTR + 32 * ks;
                    va[4 * dt + ks] = __builtin_shufflevector(*(const LAS s16x4*)vp, *(const LAS s16x4*)(vp + 16), 0, 1, 2, 3, 4, 5, 6, 7); }
            __builtin_amdgcn_sched_barrier(0); }
            const int kbase = 64 * j;
            const bool diag = (kbase + 63 > qw0);
            if (MODE == AT_RET) {
                const float rowf = xscale * __builtin_amdgcn_exp2f(lg * (float)(t - kbase - 63));
#pragma unroll
                for (int g = 0; g < 4; ++g) {
                    const f32x4 c0 = *(const LAS f32x4*)(tab + 8 * g + 4 * hf), c1 = *(const LAS f32x4*)(tab + 32 + 8 * g + 4 * hf);
#pragma unroll
                    for (int q = 0; q < 4; ++q) { const int r = 4 * g + q;
                        s0[r] = s0[r] * (rowf * c0[q]); s1[r] = s1[r] * (rowf * c1[q]); }
                }
                if (diag) {
#pragma unroll
                    for (int r = 0; r < 16; ++r) { const int key = kbase + crow(r, hf); if (key > t) s0[r] = 0.f; if (key + 32 > t) s1[r] = 0.f; } }
            } else {
                float mloc = -__builtin_inff();
                if (MODE == AT_FOX) {
                    const LAS float* ck = (const LAS float*)(vb + AT_VBYTES);
#pragma unroll
                    for (int g = 0; g < 4; ++g) {
                        const f32x4 c0 = *(const LAS f32x4*)(ck + 8 * g + 4 * hf), c1 = *(const LAS f32x4*)(ck + 32 + 8 * g + 4 * hf);
#pragma unroll
                        for (int q = 0; q < 4; ++q) { const int r = 4 * g + q; s0[r] = fmaf(s0[r], xscale, -c0[q]); s1[r] = fmaf(s1[r], xscale, -c1[q]); }
                    }
                    if (diag) {
#pragma unroll
                        for (int r = 0; r < 16; ++r) { const int key = kbase + crow(r, hf); if (key > t) s0[r] = -__builtin_inff(); if (key + 32 > t) s1[r] = -__builtin_inff(); } }
#pragma unroll
                    for (int r = 0; r < 16; ++r) mloc = fmaxf(mloc, fmaxf(s0[r], s1[r]));
                } else {
                    const unsigned long long mw = mtile; const int mlo = (int)(unsigned)mw, mhi = (int)(unsigned)(mw >> 32);
                    const float bconst = tab[512 + head]; const bool btab = (qw0 - (kbase + 63) < 113);
#pragma unroll
                    for (int r = 0; r < 16; ++r) { const int kk = crow(r, hf); const int key = kbase + kk;
                        float b0 = bconst, b1 = bconst;
                        if (btab) { int r0 = t - key; r0 = r0 < 0 ? 0 : (r0 > 127 ? 128 : r0); int r1 = t - key - 32; r1 = r1 < 0 ? 0 : (r1 > 127 ? 128 : r1);
                            b0 = r0 == 128 ? bconst : tab[head * 128 + r0]; b1 = r1 == 128 ? bconst : tab[head * 128 + r1]; }
                        const float x0 = fmaf(s0[r], xscale, b0), x1 = fmaf(s1[r], xscale, b1);
                        const int k0 = __builtin_amdgcn_sbfe(mlo, kk, 1), k1 = __builtin_amdgcn_sbfe(mhi, kk, 1);
                        s0[r] = __int_as_float((__float_as_int(x0) & k0) | (~k0 & (int)0xff800000)); s1[r] = __int_as_float((__float_as_int(x1) & k1) | (~k1 & (int)0xff800000));
                        mloc = fmaxf(mloc, fmaxf(s0[r], s1[r])); }
                }
                mloc = fmaxf(mloc, __shfl_xor(mloc, 32));
                const float mnew = fmaxf(mrun, mloc);
                if (__any(mnew > mrun)) {
                    const float alpha = __builtin_amdgcn_exp2f(mrun - mnew); mrun = mnew;
                    lsum *= alpha;
#pragma unroll
                    for (int i = 0; i < 4; ++i)
#pragma unroll
                        for (int r = 0; r < 16; ++r) o[i][r] *= alpha;
                }
                float ps = 0.f;
#pragma unroll
                for (int r = 0; r < 16; ++r) { s0[r] = __builtin_amdgcn_exp2f(s0[r] - mnew); s1[r] = __builtin_amdgcn_exp2f(s1[r] - mnew); ps += s0[r] + s1[r]; }
                lsum += ps;
            }
            bf16x8 pf[2][2];
#pragma unroll
            for (int s2 = 0; s2 < 2; ++s2) {
                pf[0][s2] = pack8(s0[8 * s2], s0[8 * s2 + 1], s0[8 * s2 + 2], s0[8 * s2 + 3], s0[8 * s2 + 4], s0[8 * s2 + 5], s0[8 * s2 + 6], s0[8 * s2 + 7]);
                pf[1][s2] = pack8(s1[8 * s2], s1[8 * s2 + 1], s1[8 * s2 + 2], s1[8 * s2 + 3], s1[8 * s2 + 4], s1[8 * s2 + 5], s1[8 * s2 + 6], s1[8 * s2 + 7]);
            }
            if (MODE != AT_DSA) {
            bf16x8 vb2[8];
            __builtin_amdgcn_sched_barrier(0);
#pragma unroll
            for (int dt = 2; dt < 4; ++dt)
#pragma unroll
                for (int ks = 0; ks < 4; ++ks) { const LAS unsigned char* vp = vp0 + 32 * dt * AT_VSTR + 32 * ks;
                    vb2[4 * (dt - 2) + ks] = __builtin_shufflevector(*(const LAS s16x4*)vp, *(const LAS s16x4*)(vp + 16), 0, 1, 2, 3, 4, 5, 6, 7); }
            __builtin_amdgcn_sched_barrier(0);
#pragma unroll
            for (int dt = 0; dt < 2; ++dt)
#pragma unroll
                for (int ks = 0; ks < 4; ++ks) o[dt] = MFMA32(va[4 * dt + ks], pf[ks >> 1][ks & 1], o[dt]);
            __builtin_amdgcn_sched_barrier(0);
#pragma unroll
            for (int dt = 2; dt < 4; ++dt)
#pragma unroll
                for (int ks = 0; ks < 4; ++ks) o[dt] = MFMA32(vb2[4 * (dt - 2) + ks], pf[ks >> 1][ks & 1], o[dt]);
            } else {
#pragma unroll
            for (int dt = 0; dt < 4; ++dt) {
                bf16x8 vd[4];
#pragma unroll
                for (int ks = 0; ks < 4; ++ks) { const LAS unsigned char* vp = vp0 + 32 * dt * AT_VSTR + 32 * ks;
                    vd[ks] = __builtin_shufflevector(*(const LAS s16x4*)vp, *(const LAS s16x4*)(vp + 16), 0, 1, 2, 3, 4, 5, 6, 7); }
                __builtin_amdgcn_sched_barrier(0);
#pragma unroll
                for (int ks = 0; ks < 4; ++ks) o[dt] = MFMA32(vd[ks], pf[ks >> 1][ks & 1], o[dt]);
                __builtin_amdgcn_sched_barrier(0);
            } }
        }
        if (j + 1 < nkt) commit((j + 1) & 1);
        __syncthreads();
    }
    if (MODE == AT_RET) {
        const int nc0 = q0 / 128;
        const bf16_t* RT = (const bf16_t*)(c.ws + WS_KVT) + (size_t)((b * 4 + head) * 32 + nc0) * 32768;
#pragma unroll
        for (int p = 0; p < 8; ++p) { const int idx = tid + 512 * p, hsel = idx >> 11, rem = idx & 2047, row = rem >> 4, ch = rem & 15;
            *(LAS u32x4*)(lds + hsel * AT_BUF + row * AT_KSTR + ch * 16) = *(const u32x4*)(RT + (size_t)hsel * 32768 + row * 128 + ch * 8); }
        const float xi = exp2f(lg * (float)(((qw0 + l31) & 127) + 1));
#pragma unroll
        for (int s = 0; s < 8; ++s) { const u32x4 wv = __builtin_bit_cast(u32x4, qf[s]);
            qf[s] = pack8(lo_bf(wv.x) * xi, hi_bf(wv.x) * xi, lo_bf(wv.y) * xi, hi_bf(wv.y) * xi, lo_bf(wv.z) * xi, hi_bf(wv.z) * xi, lo_bf(wv.w) * xi, hi_bf(wv.w) * xi); }
        __syncthreads();
        const LAS unsigned char* rp0 = lds + (w >> 2) * AT_BUF + l31 * AT_KSTR + 16 * hf;
#pragma unroll
        for (int dt = 0; dt < 4; ++dt) {
            bf16x8 ra[8];
#pragma unroll
            for (int s = 0; s < 8; ++s) ra[s] = *(const LAS bf16x8*)(rp0 + 32 * dt * AT_KSTR + 32 * s);
            __builtin_amdgcn_sched_barrier(0);
#pragma unroll
            for (int s = 0; s < 8; ++s) o[dt] = MFMA32(ra[s], qf[s], o[dt]);
            __builtin_amdgcn_sched_barrier(0);
        }
    }
    bf16_t* Op = WSP(bf16_t, WS_BR) + (size_t)(b * SEQ + t) * D + ocol;
    if (MODE == AT_RET) {
        float s = 0.f;
#pragma unroll
        for (int i = 0; i < 4; ++i)
#pragma unroll
            for (int r = 0; r < 16; ++r) s += o[i][r];
        s += __shfl_xor(s, 32);
        const float mu = s * (1.f / 128.f); float v = 0.f;
#pragma unroll
        for (int i = 0; i < 4; ++i)
#pragma unroll
            for (int r = 0; r < 16; ++r) { const float d = o[i][r] - mu; v += d * d; }
        v += __shfl_xor(v, 32);
        const float rs = rsqrtf(v * (1.f / 128.f) + EPS);
        const bf16_t* gp = P + (size_t)(b * SEQ + t) * NP + C_RG + head * 128;
#pragma unroll
        for (int i = 0; i < 4; ++i)
#pragma unroll
            for (int g = 0; g < 4; ++g) { const int d0 = 32 * i + 8 * g + 4 * hf;
                const u32x2 gw = *(const u32x2*)(gp + d0);
                u32x2 wv; wv.x = pk2((o[i][4 * g] - mu) * rs * siluf_(lo_bf(gw.x)), (o[i][4 * g + 1] - mu) * rs * siluf_(hi_bf(gw.x)));
                wv.y = pk2((o[i][4 * g + 2] - mu) * rs * siluf_(lo_bf(gw.y)), (o[i][4 * g + 3] - mu) * rs * siluf_(hi_bf(gw.y)));
                *(u32x2*)(Op + d0) = wv; }
    } else {
        const float lt = lsum + __shfl_xor(lsum, 32), inv = 1.f / lt;
#pragma unroll
        for (int i = 0; i < 4; ++i)
#pragma unroll
            for (int g = 0; g < 4; ++g) { const int d0 = 32 * i + 8 * g + 4 * hf;
                u32x2 wv; wv.x = pk2(o[i][4 * g] * inv, o[i][4 * g + 1] * inv); wv.y = pk2(o[i][4 * g + 2] * inv, o[i][4 * g + 3] * inv);
                *(u32x2*)(Op + d0) = wv; }
    }
}

constexpr int IX_QSTR = 2064;
DI void idx_unit(const Ctx& c, int b, int q0) {
    LAS unsigned char* lds = c.lds;
    const int tid = c.tid, w = c.wave, lane = c.lane, l31 = lane & 31, hf = lane >> 5;
    const bf16_t* QD = WSP(bf16_t, WS_QD); const bf16_t* P = WSP(bf16_t, WS_PROJ); float* SC = WSP(float, WS_SC);
    const int t = q0 + l31;
    __syncthreads();
#pragma unroll
    for (int p = 0; p < 8; ++p) { const int idx = tid + 512 * p, r = idx >> 7, ch = idx & 127;
        *(LAS u32x4*)(lds + r * IX_QSTR + ch * 16) = *(const u32x4*)(QD + (size_t)(b * SEQ + q0 + r) * 1536 + 512 + ch * 8); }
    LAS float* wtab = (LAS float*)(lds + 32 * IX_QSTR);
    { const int r = tid >> 4, hh = tid & 15; wtab[hh * 32 + r] = bf2f(P[(size_t)(b * SEQ + q0 + r) * NP + C_IW + hh]) * 0.03125f; }
    __syncthreads();
    const int nkt = (q0 + 32 + 63) / 64;
    bf16x8 kn[2][4];
    { const int j0 = w < nkt ? w : 0;
#pragma unroll
      for (int k2 = 0; k2 < 2; ++k2) { const bf16_t* kp = P + (size_t)(b * SEQ + 64 * j0 + 32 * k2 + l31) * NP + C_IK + 8 * hf;
#pragma unroll
          for (int s = 0; s < 4; ++s) kn[k2][s] = *(const bf16x8*)(kp + 16 * s); } }
    for (int jt = w; jt < nkt; jt += 8) {
        bf16x8 kf[2][4];
#pragma unroll
        for (int k2 = 0; k2 < 2; ++k2)
#pragma unroll
            for (int s = 0; s < 4; ++s) kf[k2][s] = kn[k2][s];
        { const int jn = jt + 8 < nkt ? jt + 8 : jt;
#pragma unroll
          for (int k2 = 0; k2 < 2; ++k2) { const bf16_t* kp = P + (size_t)(b * SEQ + 64 * jn + 32 * k2 + l31) * NP + C_IK + 8 * hf;
#pragma unroll
              for (int s = 0; s < 4; ++s) kn[k2][s] = *(const bf16x8*)(kp + 16 * s); } }
        f32x16 a0, a1;
#pragma unroll
        for (int r = 0; r < 16; ++r) { a0[r] = 0.f; a1[r] = 0.f; }
#pragma unroll 1
        for (int h = 0; h < 16; ++h) {
            f32x16 c0, c1;
#pragma unroll
            for (int r = 0; r < 16; ++r) { c0[r] = 0.f; c1[r] = 0.f; }
            const float wh = wtab[h * 32 + l31];
            const LAS unsigned char* qp = lds + l31 * IX_QSTR + h * 128 + 16 * hf;
#pragma unroll
            for (int s = 0; s < 4; ++s) { const bf16x8 bq = *(const LAS bf16x8*)(qp + 32 * s);
                c0 = MFMA32(kf[0][s], bq, c0); c1 = MFMA32(kf[1][s], bq, c1); }
#pragma unroll
            for (int r = 0; r < 16; ++r) { a0[r] += wh * fmaxf(c0[r], 0.f); a1[r] += wh * fmaxf(c1[r], 0.f); }
        }
        float* dst = SC + (size_t)(b * SEQ + t) * SC_LD + 64 * jt + 4 * hf;
#pragma unroll
        for (int g = 0; g < 4; ++g) { *(f32x4*)(dst + 8 * g) = (f32x4){a0[4 * g], a0[4 * g + 1], a0[4 * g + 2], a0[4 * g + 3]};
            *(f32x4*)(dst + 32 + 8 * g) = (f32x4){a1[4 * g], a1[4 * g + 1], a1[4 * g + 2], a1[4 * g + 3]}; }
    }
}
constexpr int SEL_WORDS = 2048 + 256 + 64;
DI int sel_bin(float v, float scale, float off) { return (int)__builtin_amdgcn_fmed3f(fmaf(v, scale, off), 0.f, 2047.f); }
DI void select_rows(const Ctx& c) {
    const int gw = c.bid * 8 + c.wave, NGW = c.G * 8;
    const float* SC = WSP(float, WS_SC); unsigned long long* MK = WSP(unsigned long long, WS_MASK);
    LAS unsigned* hist = (LAS unsigned*)(c.lds) + c.wave * SEL_WORDS;
    LAS float* list = (LAS float*)(hist + 2048);
    const float NINF = -__builtin_inff(), PINF = __builtin_inff();
    for (int m = gw; m < M; m += NGW) {
        int lane = c.lane; asm volatile("" : "+v"(lane));
        const int t = m & (SEQ - 1), jmax = t >> 6;
        const float* row = SC + (size_t)m * SC_LD;
        float val[64];
#pragma unroll
        for (int j = 0; j < 64; ++j) val[j] = NINF;
#pragma unroll
        for (int j8 = 0; j8 < 8; ++j8) {
            if (8 * j8 + 7 < jmax) {
#pragma unroll
                for (int j = 8 * j8; j < 8 * j8 + 8; ++j) val[j] = row[64 * j + lane]; }
            else if (8 * j8 <= jmax) {
#pragma unroll
                for (int j = 8 * j8; j < 8 * j8 + 8; ++j) { const int s = 64 * j + lane; const float v = row[s <= t ? s : t]; val[j] = s <= t ? v : NINF; } } }
        float thr = NINF;
        if (t >= 256) {
            float lo = PINF, hi = NINF;
#pragma unroll
            for (int j8 = 0; j8 < 8; ++j8) {
                if (8 * j8 + 7 < jmax) {
#pragma unroll
                    for (int j = 8 * j8; j < 8 * j8 + 8; ++j) { hi = fmaxf(hi, val[j]); lo = fminf(lo, val[j]); } }
                else if (8 * j8 <= jmax) {
#pragma unroll
                    for (int j = 8 * j8; j < 8 * j8 + 8; ++j) { hi = fmaxf(hi, val[j]); lo = fminf(lo, val[j] == NINF ? PINF : val[j]); } } }
#pragma unroll
            for (int o = 1; o < 64; o <<= 1) { hi = fmaxf(hi, __shfl_xor(hi, o)); lo = fminf(lo, __shfl_xor(lo, o)); }
            const float scale = (hi > lo) ? 2046.f / (hi - lo) : 0.f, off = 1.f - lo * scale;
            asm volatile("s_waitcnt lgkmcnt(0)" ::: "memory");
#pragma unroll
            for (int q = 0; q < 8; ++q) *(LAS u32x4*)(hist + 32 * lane + 4 * q) = (u32x4){0u, 0u, 0u, 0u};
            asm volatile("s_waitcnt lgkmcnt(0)" ::: "memory");
#pragma unroll
            for (int j8 = 0; j8 < 8; ++j8) if (8 * j8 <= jmax) {
#pragma unroll
                for (int j = 8 * j8; j < 8 * j8 + 8; ++j) __hip_atomic_fetch_add(hist + sel_bin(val[j], scale, off), 1u, __ATOMIC_RELAXED, __HIP_MEMORY_SCOPE_WORKGROUP); }
            asm volatile("s_waitcnt lgkmcnt(0)" ::: "memory");
            int T = 0;
#pragma unroll
            for (int q = 0; q < 8; ++q) { const u32x4 v = *(const LAS u32x4*)(hist + 32 * lane + 4 * q); T += (int)(v.x + v.y + v.z + v.w); }
            if (lane == 0) T -= (int)hist[0];
            int S = T;
#pragma unroll
            for (int o = 1; o < 64; o <<= 1) { const int v = __shfl_down(S, o); if (lane + o < 64) S += v; }
            const unsigned long long bm = __ballot(S >= 256);
            const int L = 63 - __builtin_clzll(bm | 1ull);
            const int need2 = 256 - (S - T);
            int run = 0, bsel = 0, above = 0, inb = 0; bool found = false;
#pragma unroll
            for (int q = 7; q >= 0; --q) { const u32x4 v = *(const LAS u32x4*)(hist + 32 * lane + 4 * q);
#pragma unroll
                for (int e = 3; e >= 0; --e) { const int h = (int)v[e]; run += h; if (!found && run >= need2) { found = true; bsel = 4 * q + e; above = run - h; inb = h; } } }
            const int B0 = 32 * L + __builtin_amdgcn_readlane(bsel, L);
            const int need = __builtin_amdgcn_readlane(need2, L) - __builtin_amdgcn_readlane(above, L);
            const int cnt = __builtin_amdgcn_readlane(inb, L);
            if (cnt <= 256 && B0 > 0) {
                int pos = 0;
#pragma unroll
                for (int j8 = 0; j8 < 8; ++j8) if (8 * j8 <= jmax) {
#pragma unroll
                  for (int j = 8 * j8; j < 8 * j8 + 8; ++j) { const float v = val[j];
                    const bool in = sel_bin(v, scale, off) == B0;
                    const unsigned long long mm = __ballot(in);
                    if (mm != 0ull) { const int p = pos + (int)__builtin_amdgcn_mbcnt_hi((unsigned)(mm >> 32), __builtin_amdgcn_mbcnt_lo((unsigned)mm, 0u)); if (in) list[p] = v; pos += __builtin_popcountll(mm); }
                    if ((j & 3) == 3) __builtin_amdgcn_sched_barrier(0); } }
                asm volatile("s_waitcnt lgkmcnt(0)" ::: "memory");
                float best = NINF;
                for (int i0 = 0; i0 < cnt; i0 += 64) { const int i = i0 + lane; const float mine = i < cnt ? list[i] : PINF; int rk = 0;
                    for (int k = 0; k < cnt; ++k) rk += (list[k] >= mine) ? 1 : 0;
                    if (i < cnt && rk >= need) best = fmaxf(best, mine); }
#pragma unroll
                for (int o = 1; o < 64; o <<= 1) best = fmaxf(best, __shfl_xor(best, o));
                thr = best;
            } else {
                unsigned prefix = 0u;
                for (int bit = 31; bit >= 0; --bit) { const unsigned cand = prefix | (1u << bit); int cn = 0;
#pragma unroll
                    for (int j = 0; j < 64; ++j) { const unsigned u = __float_as_uint(val[j]); const unsigned k = val[j] == NINF ? 0u : ((u & 0x80000000u) ? ~u : (u | 0x80000000u)); cn += (k >= cand) ? 1 : 0; }
#pragma unroll
                    for (int o = 1; o < 64; o <<= 1) cn += __shfl_xor(cn, o);
                    if (cn >= 256) prefix = cand; }
                thr = __uint_as_float((prefix & 0x80000000u) ? (prefix & 0x7fffffffu) : ~prefix);
            }
        }
        int mlo = 0, mhi = 0;
#pragma unroll
        for (int j8 = 0; j8 < 8; ++j8) if (8 * j8 <= jmax) {
#pragma unroll
          for (int j = 8 * j8; j < 8 * j8 + 8; ++j) { const unsigned long long bm = __ballot(val[j] >= thr);
            asm volatile("s_nop 4\n\tv_writelane_b32 %0, %2, %4\n\tv_writelane_b32 %1, %3, %4" : "+v"(mlo), "+v"(mhi) : "s"((unsigned)bm), "s"((unsigned)(bm >> 32)), "n"(j)); } }
        unsigned long long mine = ((unsigned long long)(unsigned)mhi << 32) | (unsigned)mlo;
        if (t < 256) mine = (64 * lane + 63 <= t) ? ~0ull : (64 * lane > t ? 0ull : ((2ull << (t - 64 * lane)) - 1ull));
        MK[(size_t)m * 64 + lane] = mine;
    }
}
constexpr int GP_KN = 0;
constexpr int GP_VV = 33024;
constexpr int GP_KB = 65792;
constexpr int GP_QB = 83200;
constexpr int GP_L = 100608;
constexpr int GP_BETA = 118016, GP_G = 118272, GP_EG = 118528;
DI void gdn_prep(const Ctx& c, int l, int unit) {
    LAS unsigned char* lds = c.lds;
    const int tid = c.tid, w = c.wave, lane = c.lane, l31 = lane & 31, hf = lane >> 5;
    const int n = unit & 63, h = (unit >> 6) & 3, b = unit >> 8;
    const int row0 = b * SEQ + n * 64;
    const bf16_t* P = WSP(bf16_t, WS_PROJ);
    LAS float* kn = (LAS float*)(lds + GP_KN); LAS float* vv = (LAS float*)(lds + GP_VV);
    LAS bf16_t* kb = (LAS bf16_t*)(lds + GP_KB); LAS bf16_t* qb = (LAS bf16_t*)(lds + GP_QB);
    LAS float* Lm = (LAS float*)(lds + GP_L); LAS float* beta = (LAS float*)(lds + GP_BETA); LAS float* gg = (LAS float*)(lds + GP_G); LAS float* eg = (LAS float*)(lds + GP_EG);
    __syncthreads();
    if (w == 0) {
        const float bl = bf2f(P[(size_t)(row0 + lane) * NP + C_GB + h]), al = bf2f(P[(size_t)(row0 + lane) * NP + C_GA + h]);
        const float A = __expf(INP(IN_GDN_ALOG)[l * 4 + h]); const float xx = al + INP(IN_GDN_DT)[l * 4 + h];
        const float sp = xx > 20.f ? xx : __logf(1.f + __expf(xx));
        float g = -A * sp;
#pragma unroll
        for (int o = 1; o < 64; o <<= 1) { const float tt = __shfl_up(g, o); if (lane >= o) g += tt; }
        beta[lane] = sigmoidf_(bl); gg[lane] = g; eg[lane] = __expf(g);
    }
    {
        const int tok = tid >> 3, part = tid & 7, pos = n * 64 + tok;
        const float* cwl = INP(IN_GDN_CONV) + (size_t)l * 4 * 1536;
#pragma unroll
        for (int which = 0; which < 3; ++which) {
            const int ccol = which * 512 + h * 128 + 16 * part;
            float y[16];
#pragma unroll
            for (int e = 0; e < 16; ++e) y[e] = 0.f;
#pragma unroll
            for (int i = 0; i < 4; ++i) {
                {
                    const int dlt = (pos - 3 + i >= 0) ? (i - 3) : 0;
                    const float live = (pos - 3 + i >= 0) ? 1.f : 0.f;
                    const bf16_t* src = P + (size_t)(row0 + tok + dlt) * NP + C_GQ + ccol;
                    const u32x4 x0 = *(const u32x4*)src, x1 = *(const u32x4*)(src + 8);
                    const float* wp = cwl + i * 1536 + ccol;
                    const f32x4 w0 = *(const f32x4*)wp * live, w1 = *(const f32x4*)(wp + 4) * live, w2 = *(const f32x4*)(wp + 8) * live, w3 = *(const f32x4*)(wp + 12) * live;
                    y[0] += w0.x * lo_bf(x0.x); y[1] += w0.y * hi_bf(x0.x); y[2] += w0.z * lo_bf(x0.y); y[3] += w0.w * hi_bf(x0.y);
                    y[4] += w1.x * lo_bf(x0.z); y[5] += w1.y * hi_bf(x0.z); y[6] += w1.z * lo_bf(x0.w); y[7] += w1.w * hi_bf(x0.w);
                    y[8] += w2.x * lo_bf(x1.x); y[9] += w2.y * hi_bf(x1.x); y[10] += w2.z * lo_bf(x1.y); y[11] += w2.w * hi_bf(x1.y);
                    y[12] += w3.x * lo_bf(x1.z); y[13] += w3.y * hi_bf(x1.z); y[14] += w3.z * lo_bf(x1.w); y[15] += w3.w * hi_bf(x1.w);
                }
            }
            float ss = 0.f;
#pragma unroll
            for (int e = 0; e < 16; ++e) { y[e] = siluf_(y[e]); ss += y[e] * y[e]; }
            if (which < 2) {
                ss += __shfl_xor(ss, 1); ss += __shfl_xor(ss, 2); ss += __shfl_xor(ss, 4);
                const float r = rsqrtf(ss + EPS) * (which == 0 ? SM_SCALE : 1.f);
#pragma unroll
                for (int e = 0; e < 16; ++e) y[e] *= r;
                LAS bf16_t* dstb = (which == 0 ? qb : kb) + tok * 136 + 16 * part;
#pragma unroll
                for (int e = 0; e < 16; e += 2) *(LAS unsigned*)(dstb + e) = pk2(y[e], y[e + 1]);
                if (which == 1) {
#pragma unroll
                    for (int e = 0; e < 16; ++e) kn[tok * 129 + 16 * part + e] = y[e]; }
            } else {
#pragma unroll
                for (int e = 0; e < 16; ++e) vv[tok * 128 + 16 * part + e] = y[e];
            }
        }
    }
    __syncthreads();
    {
        const int which = w >> 2, ti = (w >> 1) & 1, tj = w & 1;
        const LAS bf16_t* Ab = (which ? qb : kb) + (32 * ti + l31) * 136 + 8 * hf;
        const LAS bf16_t* Bb = kb + (32 * tj + l31) * 136 + 8 * hf;
        f32x16 acc;
#pragma unroll
        for (int r = 0; r < 16; ++r) acc[r] = 0.f;
#pragma unroll
        for (int s = 0; s < 8; ++s) acc = MFMA32(*(const LAS bf16x8*)(Ab + 16 * s), *(const LAS bf16x8*)(Bb + 16 * s), acc);
        const int sc = 32 * tj + l31; const float gs = gg[sc];
        bf16_t* QKM = WSP(bf16_t, WS_QKM) + (size_t)unit * 4096;
#pragma unroll
        for (int r = 0; r < 16; ++r) { const int cc = 32 * ti + crow(r, hf);
            const float dec = __expf(fminf(gg[cc] - gs, 0.f));
            if (which == 0) Lm[sc * 68 + cc] = (cc > sc) ? beta[cc] * acc[r] * dec : 0.f;
            else QKM[cc * 64 + sc] = f2bf((cc >= sc) ? acc[r] * dec : 0.f); }
    }
    __syncthreads();
    if (tid < 256) {
        float x[64];
        if (tid < 128) {
#pragma unroll
            for (int i = 0; i < 64; ++i) x[i] = vv[i * 128 + tid] * beta[i]; }
        else {
#pragma unroll
            for (int i = 0; i < 64; ++i) x[i] = kn[i * 129 + tid - 128] * (beta[i] * eg[i]); }
        int zv = 0; asm volatile("" : "+v"(zv));
        const LAS float* Lz = Lm + zv;
        f32x4 colv[2][16];
#pragma unroll
        for (int g = 0; g < 16; ++g) colv[0][g] = *(const LAS f32x4*)(Lz + 4 * g);
#pragma unroll
        for (int j = 0; j < 63; ++j) { const float xj = x[j];
            if (j + 1 < 63) {
#pragma unroll
                for (int g = (j + 2) >> 2; g < 16; ++g) colv[(j + 1) & 1][g] = *(const LAS f32x4*)(Lz + (j + 1) * 68 + 4 * g); }
            __builtin_amdgcn_sched_barrier(0);
#pragma unroll
            for (int g = (j + 1) >> 2; g < 16; ++g) { const f32x4 lv = colv[j & 1][g];
                x[4 * g] -= lv.x * xj; x[4 * g + 1] -= lv.y * xj; x[4 * g + 2] -= lv.z * xj; x[4 * g + 3] -= lv.w * xj; }
            __builtin_amdgcn_sched_barrier(0); }
        if (tid < 128) { float* U0 = WSP(float, WS_U0) + (size_t)row0 * 512 + h * 128 + tid;
#pragma unroll
            for (int i = 0; i < 64; ++i) U0[(size_t)i * 512] = x[i]; }
        else { bf16_t* KC = WSP(bf16_t, WS_KCUM) + (size_t)row0 * 512 + h * 128 + tid - 128;
#pragma unroll
            for (int i = 0; i < 64; ++i) KC[(size_t)i * 512] = f2bf(x[i]); }
    } else {
        const int t2 = tid - 256; const float gl = gg[63];
        bf16_t* QDEC = WSP(bf16_t, WS_QDEC) + (size_t)row0 * 512 + h * 128;
#pragma unroll 4
        for (int k = 0; k < 32; ++k) { const int e = t2 + 256 * k, cc = e >> 7, d = e & 127; QDEC[(size_t)cc * 512 + d] = f2bf(bf2f(qb[cc * 136 + d]) * eg[cc]); }
        bf16_t* KDT = WSP(bf16_t, WS_KDT) + (size_t)unit * 8192;
#pragma unroll 4
        for (int k = 0; k < 32; ++k) { const int e = t2 + 256 * k, d = e >> 6, cc = e & 63; KDT[d * 64 + cc] = f2bf(kn[cc * 129 + d] * __expf(gl - gg[cc])); }
        if (t2 == 0) WSP(float, WS_EGL)[unit] = __expf(gl);
    }
}

constexpr int GS_KC = 0, GS_QD = 16896, GS_QK = 33792, GS_KD = 42496, GS_BUF = 59904;
DI void gdn_scan(const Ctx& c, int item) {
    LAS unsigned char* lds = c.lds;
    const int tid = c.tid, w = c.wave, lane = c.lane, l31 = lane & 31, hf = lane >> 5;
    const int b = item >> 2, h = item & 3;
    const bf16_t* KC = WSP(bf16_t, WS_KCUM) + (size_t)(b * SEQ) * 512 + h * 128;
    const bf16_t* QDc = WSP(bf16_t, WS_QDEC) + (size_t)(b * SEQ) * 512 + h * 128;
    const bf16_t* QKM = WSP(bf16_t, WS_QKM) + (size_t)(b * 4 + h) * 64 * 4096;
    const bf16_t* KDT = WSP(bf16_t, WS_KDT) + (size_t)(b * 4 + h) * 64 * 8192;
    const float* U0 = WSP(float, WS_U0) + (size_t)(b * SEQ) * 512 + h * 128;
    const float* EGL = WSP(float, WS_EGL) + (b * 4 + h) * 64;
    float* OG = WSP(float, WS_OG) + (size_t)(b * SEQ) * 512 + h * 128;
    u32x4 stA[14], stB[14];
#define GS_ISSUE(n_, st) do { const int t2 = tid - 256; \
        _Pragma("unroll") for (int k = 0; k < 4; ++k) { const int idx = t2 + 256 * k, cc = idx >> 4, ch = idx & 15; \
            st[k] = *(const u32x4*)(KC + (size_t)((n_) * 64 + cc) * 512 + ch * 8); st[4 + k] = *(const u32x4*)(QDc + (size_t)((n_) * 64 + cc) * 512 + ch * 8); } \
        _Pragma("unroll") for (int k = 0; k < 2; ++k) { const int idx = t2 + 256 * k; st[8 + k] = *(const u32x4*)(QKM + (size_t)(n_) * 4096 + idx * 8); } \
        _Pragma("unroll") for (int k = 0; k < 4; ++k) { const int idx = t2 + 256 * k; st[10 + k] = *(const u32x4*)(KDT + (size_t)(n_) * 8192 + idx * 8); } } while (0)
#define GS_COMMIT(buf_, st) do { const int t2 = tid - 256; LAS unsigned char* bb = lds + (buf_) * GS_BUF; \
        _Pragma("unroll") for (int k = 0; k < 4; ++k) { const int idx = t2 + 256 * k, cc = idx >> 4, ch = idx & 15; \
            LAS u32x2* d0 = (LAS u32x2*)(bb + GS_KC + cc * 264 + ch * 16); d0[0] = (u32x2){st[k].x, st[k].y}; d0[1] = (u32x2){st[k].z, st[k].w}; \
            LAS u32x2* d1 = (LAS u32x2*)(bb + GS_QD + cc * 264 + ch * 16); d1[0] = (u32x2){st[4 + k].x, st[4 + k].y}; d1[1] = (u32x2){st[4 + k].z, st[4 + k].w}; } \
        _Pragma("unroll") for (int k = 0; k < 2; ++k) { const int idx = t2 + 256 * k, cc = idx >> 3, ch = idx & 7; \
            LAS u32x2* d0 = (LAS u32x2*)(bb + GS_QK + cc * 136 + ch * 16); d0[0] = (u32x2){st[8 + k].x, st[8 + k].y}; d0[1] = (u32x2){st[8 + k].z, st[8 + k].w}; } \
        _Pragma("unroll") for (int k = 0; k < 4; ++k) { const int idx = t2 + 256 * k, dd = idx >> 3, ch = idx & 7; \
            LAS u32x2* d0 = (LAS u32x2*)(bb + GS_KD + dd * 136 + ch * 16); d0[0] = (u32x2){st[10 + k].x, st[10 + k].y}; d0[1] = (u32x2){st[10 + k].z, st[10 + k].w}; } } while (0)
    __syncthreads();
    if (w >= 4) { GS_ISSUE(0, stA); GS_COMMIT(0, stA); }
    __syncthreads();
    if (w >= 4) {
        GS_ISSUE(1, stA);
        for (int n = 0; n < 64; n += 2) {
            if (n + 2 < 64) GS_ISSUE(n + 2, stB);
            if (n + 1 < 64) GS_COMMIT((n + 1) & 1, stA);
            __syncthreads();
            if (n + 3 < 64) GS_ISSUE(n + 3, stA);
            if (n + 2 < 64) GS_COMMIT(n & 1, stB);
            __syncthreads();
        }
    } else {
    f32x16 S[4];
#pragma unroll
    for (int i = 0; i < 4; ++i)
#pragma unroll
        for (int r = 0; r < 16; ++r) S[i][r] = 0.f;
    f32x16 u[2]; float egl_n = 0.f;
    if (w < 4) { const int e0 = 32 * w + l31;
#pragma unroll
        for (int ct = 0; ct < 2; ++ct)
#pragma unroll
            for (int r = 0; r < 16; ++r) u[ct][r] = U0[(size_t)(32 * ct + crow(r, hf)) * 512 + e0];
        egl_n = EGL[0]; }
    for (int n = 0; n < 64; ++n) {
        {
            const LAS unsigned char* bb = lds + (n & 1) * GS_BUF;
            const int e0 = 32 * w + l31;
            const float egl = egl_n;
            bf16x8 Sb[8];
#pragma unroll
            for (int dt = 0; dt < 4; ++dt)
#pragma unroll
                for (int s2 = 0; s2 < 2; ++s2) Sb[2 * dt + s2] = pack8(S[dt][8 * s2], S[dt][8 * s2 + 1], S[dt][8 * s2 + 2], S[dt][8 * s2 + 3], S[dt][8 * s2 + 4], S[dt][8 * s2 + 5], S[dt][8 * s2 + 6], S[dt][8 * s2 + 7]);
#define GS_FRAG(p) __builtin_shufflevector(*(const LAS s16x4*)(p), *(const LAS s16x4*)((p) + 16), 0, 1, 2, 3, 4, 5, 6, 7)
            f32x16 a1[2];
#pragma unroll
            for (int ct = 0; ct < 2; ++ct) {
#pragma unroll
                for (int r = 0; r < 16; ++r) a1[ct][r] = 0.f;
                bf16x8 fr[8];
#pragma unroll
                for (int ks = 0; ks < 8; ++ks) fr[ks] = GS_FRAG(bb + GS_KC + (32 * ct + l31) * 264 + (16 * ks + 4 * hf) * 2);
                __builtin_amdgcn_sched_barrier(0);
#pragma unroll
                for (int ks = 0; ks < 8; ++ks) a1[ct] = MFMA32(fr[ks], Sb[ks], a1[ct]);
                __builtin_amdgcn_sched_barrier(0);
            }
            bf16x8 vb[4];
#pragma unroll
            for (int ct = 0; ct < 2; ++ct) {
#pragma unroll
                for (int r = 0; r < 16; ++r) u[ct][r] -= a1[ct][r];
#pragma unroll
                for (int s2 = 0; s2 < 2; ++s2) vb[2 * ct + s2] = pack8(u[ct][8 * s2], u[ct][8 * s2 + 1], u[ct][8 * s2 + 2], u[ct][8 * s2 + 3], u[ct][8 * s2 + 4], u[ct][8 * s2 + 5], u[ct][8 * s2 + 6], u[ct][8 * s2 + 7]);
            }
            f32x16 oo[2];
#pragma unroll
            for (int ct = 0; ct < 2; ++ct) {
#pragma unroll
                for (int r = 0; r < 16; ++r) oo[ct][r] = 0.f;
                bf16x8 fr[8];
#pragma unroll
                for (int ks = 0; ks < 8; ++ks) fr[ks] = GS_FRAG(bb + GS_QD + (32 * ct + l31) * 264 + (16 * ks + 4 * hf) * 2);
                __builtin_amdgcn_sched_barrier(0);
#pragma unroll
                for (int ks = 0; ks < 8; ++ks) oo[ct] = MFMA32(fr[ks], Sb[ks], oo[ct]);
                __builtin_amdgcn_sched_barrier(0);
            }
            { bf16x8 fr[8];
#pragma unroll
              for (int ct = 0; ct < 2; ++ct)
#pragma unroll
                  for (int ks = 0; ks < 4; ++ks) fr[4 * ct + ks] = GS_FRAG(bb + GS_QK + (32 * ct + l31) * 136 + (16 * ks + 4 * hf) * 2);
              __builtin_amdgcn_sched_barrier(0);
#pragma unroll
              for (int ct = 0; ct < 2; ++ct)
#pragma unroll
                  for (int ks = 0; ks < 4; ++ks) oo[ct] = MFMA32(fr[4 * ct + ks], vb[ks], oo[ct]);
              __builtin_amdgcn_sched_barrier(0); }
#pragma unroll
            for (int ct = 0; ct < 2; ++ct)
#pragma unroll
                for (int r = 0; r < 16; ++r) OG[(size_t)(n * 64 + 32 * ct + crow(r, hf)) * 512 + e0] = oo[ct][r];
            { const int nn = n + 1 < 64 ? n + 1 : n;
#pragma unroll
              for (int ct = 0; ct < 2; ++ct)
#pragma unroll
                  for (int r = 0; r < 16; ++r) u[ct][r] = U0[(size_t)(nn * 64 + 32 * ct + crow(r, hf)) * 512 + e0];
              egl_n = EGL[nn]; }
#pragma unroll
            for (int dh = 0; dh < 2; ++dh) {
                bf16x8 fr[8];
#pragma unroll
                for (int d2 = 0; d2 < 2; ++d2)
#pragma unroll
                    for (int ks = 0; ks < 4; ++ks) fr[4 * d2 + ks] = GS_FRAG(bb + GS_KD + (32 * (2 * dh + d2) + l31) * 136 + (16 * ks + 4 * hf) * 2);
#pragma unroll
                for (int d2 = 0; d2 < 2; ++d2)
#pragma unroll
                    for (int r = 0; r < 16; ++r) S[2 * dh + d2][r] *= egl;
                __builtin_amdgcn_sched_barrier(0);
#pragma unroll
                for (int d2 = 0; d2 < 2; ++d2)
#pragma unroll
                    for (int ks = 0; ks < 4; ++ks) S[2 * dh + d2] = MFMA32(fr[4 * d2 + ks], vb[ks], S[2 * dh + d2]);
                __builtin_amdgcn_sched_barrier(0);
            }
#undef GS_FRAG
        }
        __syncthreads();
    }
    }
}

DI void ret_chunk_kv(const Ctx& c, int unit) {
    LAS unsigned char* lds = c.lds;
    const int tid = c.tid, w = c.wave, lane = c.lane, l31 = lane & 31, hf = lane >> 5;
    const int n = unit & 31, h = (unit >> 5) & 3, b = unit >> 7;
    const int row0 = b * SEQ + 128 * n;
    const bf16_t* P = WSP(bf16_t, WS_PROJ);
    const float* cs = WSP(float, WS_ROPE); const float* sn = cs + SEQ * 64;
    LAS bf16_t* Vt = (LAS bf16_t*)lds; LAS bf16_t* Kt = (LAS bf16_t*)(lds + 128 * 272);
    const float lg = log2f(1.f - exp2f(-5.f - (float)h));
    __syncthreads();
#pragma unroll
    for (int p = 0; p < 4; ++p) { const int idx = tid + 512 * p, cc = idx >> 4, e8 = (idx & 15) * 8;
        const u32x4 vv = *(const u32x4*)(P + (size_t)(row0 + cc) * NP + C_RV + h * 128 + e8);
#pragma unroll
        for (int q = 0; q < 4; ++q) { Vt[(e8 + 2 * q) * 136 + cc] = (bf16_t)(vv[q] & 0xffffu); Vt[(e8 + 2 * q + 1) * 136 + cc] = (bf16_t)(vv[q] >> 16); } }
#pragma unroll
    for (int p = 0; p < 2; ++p) { const int idx = tid + 512 * p, cc = idx >> 3, i8 = (idx & 7) * 8;
        const bf16_t* kp = P + (size_t)(row0 + cc) * NP + C_RK + h * 128 + i8;
        const u32x4 k1 = *(const u32x4*)kp, k2 = *(const u32x4*)(kp + 64);
        const int pos = 128 * n + cc; const float zs = SM_SCALE * exp2f(lg * (float)(127 - cc));
        const f32x4 c0 = *(const f32x4*)(cs + pos * 64 + i8), c1 = *(const f32x4*)(cs + pos * 64 + i8 + 4), s0 = *(const f32x4*)(sn + pos * 64 + i8), s1 = *(const f32x4*)(sn + pos * 64 + i8 + 4);
#pragma unroll
        for (int q = 0; q < 4; ++q) {
            const float a0 = lo_bf(k1[q]), a1 = hi_bf(k1[q]), b0 = lo_bf(k2[q]), b1 = hi_bf(k2[q]);
            const float co0 = q < 2 ? c0[2 * q] : c1[2 * q - 4], co1 = q < 2 ? c0[2 * q + 1] : c1[2 * q - 3], si0 = q < 2 ? s0[2 * q] : s1[2 * q - 4], si1 = q < 2 ? s0[2 * q + 1] : s1[2 * q - 3];
            Kt[(i8 + 2 * q) * 136 + cc] = f2bf((a0 * co0 - b0 * si0) * zs); Kt[(i8 + 2 * q + 1) * 136 + cc] = f2bf((a1 * co1 - b1 * si1) * zs);
            Kt[(64 + i8 + 2 * q) * 136 + cc] = f2bf((a0 * si0 + b0 * co0) * zs); Kt[(64 + i8 + 2 * q + 1) * 136 + cc] = f2bf((a1 * si1 + b1 * co1) * zs); } }
    __syncthreads();
    float* KV = (float*)(c.ws + WS_KVT) + (size_t)unit * 16384;
    const int ei = w >> 1;
    bf16x8 af[8];
#pragma unroll
    for (int s = 0; s < 8; ++s) af[s] = *(const LAS bf16x8*)((LAS unsigned char*)Vt + (32 * ei + l31) * 272 + (16 * s + 8 * hf) * 2);
#pragma unroll
    for (int dd = 0; dd < 2; ++dd) { const int di = 2 * (w & 1) + dd;
        bf16x8 bf[8];
#pragma unroll
        for (int s = 0; s < 8; ++s) bf[s] = *(const LAS bf16x8*)((LAS unsigned char*)Kt + (32 * di + l31) * 272 + (16 * s + 8 * hf) * 2);
        f32x16 acc;
#pragma unroll
        for (int r = 0; r < 16; ++r) acc[r] = 0.f;
#pragma unroll
        for (int s = 0; s < 8; ++s) acc = MFMA32(af[s], bf[s], acc);
#pragma unroll
        for (int r = 0; r < 16; ++r) KV[(32 * ei + crow(r, hf)) * 128 + 32 * di + l31] = acc[r];
    }
}
DI void ret_scan(const Ctx& c, int item) {
    const int h = item & 3; const int tid = c.tid;
    float* base = (float*)(c.ws + WS_KVT) + (size_t)item * 32 * 16384;
    const float gc = exp2f(128.f * log2f(1.f - exp2f(-5.f - (float)h)));
    f32x4 st[8];
#pragma unroll
    for (int k = 0; k < 8; ++k) st[k] = (f32x4){0.f, 0.f, 0.f, 0.f};
    for (int n = 0; n < 32; ++n) {
        float* slot = base + (size_t)n * 16384;
        f32x4 kv[8];
#pragma unroll
        for (int k = 0; k < 8; ++k) kv[k] = *(const f32x4*)(slot + tid * 4 + 2048 * k);
        asm volatile("s_waitcnt vmcnt(0)" ::: "memory");
        __syncthreads();
#pragma unroll
        for (int k = 0; k < 8; ++k) { u32x2 wv; wv.x = pk2(st[k][0], st[k][1]); wv.y = pk2(st[k][2], st[k][3]); *(u32x2*)((bf16_t*)slot + tid * 4 + 2048 * k) = wv;
            st[k] = st[k] * gc + kv[k]; }
    }
}
constexpr int PH_PER_LAYER = 12, PH_FINAL = 1 + PH_PER_LAYER * DEPTH, N_PHASES = PH_FINAL + 1;
constexpr int LDS_INTAB = LDS_MISC + 64;
DI int qid_of(int l, int k) { return l * 16 + k; }
DI Ctx mkctx(unsigned char* ws, float* out, LAS unsigned char* lds) {
    Ctx c; c.lds = lds; c.misc = (volatile LAS unsigned*)(lds + LDS_MISC); c.ws = ws; c.ctl = (unsigned*)(ws + WS_CTL);
    c.tid = threadIdx.x; c.lane = c.tid & 63; c.wave = __builtin_amdgcn_readfirstlane(c.tid >> 6); c.G = gridDim.x; c.bid = blockIdx.x;
    c.inl = (const LAS unsigned long long*)(lds + LDS_INTAB); c.out = out; return c;
}
#define NOINL __device__ __forceinline__
#define FARGS unsigned char* ws, float* out, LAS unsigned char* lds
#define MK() Ctx c = mkctx(ws, out, lds); asm volatile("" : "+v"(c.tid)); c.lane = c.tid & 63; c.wave = __builtin_amdgcn_readfirstlane(c.tid >> 6); asm volatile("" : "+s"(c.G), "+s"(c.bid)); { unsigned char* w_ = c.ws; asm volatile("" : "+s"(w_)); c.ws = w_; c.ctl = (unsigned*)(w_ + WS_CTL); }
NOINL void f_prologue(FARGS) { MK(); make_tables(c); cvt_mixer0(c); x0_rows(c, INP(IN_X), WSP(bf16_t, WS_H), WSP(float, WS_RSP1), WSP(unsigned char, WS_XB8)); }
NOINL void f_cvt_early(FARGS, int l, int blk) { MK(); cvt_early_block(c, l, blk); }
NOINL void f_final(FARGS) { MK(); final_norm_bf(c, WSP(bf16_t, WS_H), c.out, INP(IN_FINAL_NORM)); }
NOINL void f_gemm_in(FARGS) { MK();
    { int lp = -1; pg8::Sched S8, S16; S8.init(M, 8192, c.G, c.bid, 1); S16.init(M, C_GATE, c.G, c.bid, 1);
      row_factors_units(c, WSP(float, WS_RSP1), WSP(float, WS_RF), S8, lp); row_factors_units(c, WSP(float, WS_RSP1), WSP(float, WS_RF), S16, lp); }
    { pg8::Gemm g{(const bf16_t*)WSP(unsigned char, WS_XB8), (const bf16_t*)WSP(unsigned char, WS_WG8), D / 2, D / 2, 0, 0}; pg8::Sched S; S.init(M, 8192, c.G, c.bid, 1);
      pg8::EpiGate8 E{(unsigned char*)(WSP(bf16_t, WS_PROJ) + C_GATE), (size_t)NP * 2, WSP(float, WS_RF), 0.0078125f}; pg8::gemm_phase<pg8::EpiGate8, true, true>(c.lds, g, S, E, c.tid); }
    asm volatile("" : "+v"(c.tid)); c.lane = c.tid & 63;
    { pg8::Gemm g{WSP(bf16_t, WS_H), WSP(bf16_t, WS_WIN), D, D, 0, 0}; pg8::Sched S; S.init(M, C_GATE, c.G, c.bid, 1);
      pg8::EpiBf16 E{WSP(bf16_t, WS_PROJ), NP, WSP(float, WS_RF), 1 << 30, 1.f}; pg8::gemm_phase<pg8::EpiBf16>(c.lds, g, S, E, c.tid); } }
NOINL void f_gemm_dsaq(FARGS) { MK(); pg8::Gemm g{WSP(bf16_t, WS_PROJ) + C_DCQ, WSP(bf16_t, WS_WDSA), NP, 384, 0, 0}; pg8::Sched S; S.init(M, 1536, c.G, c.bid, 1); pg8::EpiBf16 E{WSP(bf16_t, WS_QD), 1536, nullptr, 1 << 30, 1.f}; pg8::gemm_phase<pg8::EpiBf16>(c.lds, g, S, E, c.tid); }
NOINL void f_gemm_merge(FARGS) { MK(); pg8::Gemm g{WSP(bf16_t, WS_BR), WSP(bf16_t, WS_WBR), D, 512, 512 * 2, (size_t)D * 512 * 2}; pg8::Sched S; S.init(M, D, c.G, c.bid, 4); pg8::EpiMerge E{WSP(bf16_t, WS_RQ), WSP(bf16_t, WS_PROJ)};
    pg8::gemm_phase<pg8::EpiMerge>(c.lds, g, S, E, c.tid); }
NOINL void f_gemm_out(FARGS) { MK(); pg8::Gemm g{WSP(bf16_t, WS_RQ), WSP(bf16_t, WS_WOUT), D, D, 0, 0}; pg8::Sched S; S.init(M, D, c.G, c.bid, 1); pg8::EpiResid E{WSP(bf16_t, WS_H), D, WSP(float, WS_RSP2), nullptr}; pg8::gemm_phase<pg8::EpiResid>(c.lds, g, S, E, c.tid); }
NOINL void f_gemm_gate(FARGS, int l) { MK(); pg8::Gemm g{WSP(bf16_t, WS_H), WSP(bf16_t, WS_WG), D, D, 0, 0}; pg8::Sched S; S.init(M, FF, c.G, c.bid, 1);
    { int lp = -1; row_factors_units(c, WSP(float, WS_RSP2), WSP(float, WS_RF), S, lp); }
    pg8::EpiBf16 E{WSP(bf16_t, WS_G), FF, WSP(float, WS_RF), 1 << 30, 1.f}; pg8::gemm_phase<pg8::EpiBf16>(c.lds, g, S, E, c.tid);
    if (l + 1 < DEPTH && c.bid >= 128) { LAS float* scr = nullptr; const int gw = (c.bid - 128) * 8 + c.wave, NGW = (c.G - 128) * 8;
        for (int it = gw; it < CI_LATE; it += NGW) cvt_late_item(c, l + 1, it, scr); } }
NOINL void f_gemm_up(FARGS, int l) { MK(); pg8::Gemm g{WSP(bf16_t, WS_H), WSP(bf16_t, WS_WU), D, D, 0, 0}; pg8::Sched S; S.init(M, FF, c.G, c.bid, 1);
    pg8::EpiUp E{WSP(bf16_t, WS_ACT), WSP(bf16_t, WS_G), INP(IN_FFN_CONV) + (size_t)l * 3 * FF, INP(IN_FFN_CONVB) + (size_t)l * FF, WSP(float, WS_RF)}; pg8::gemm_phase<pg8::EpiUp>(c.lds, g, S, E, c.tid); }
NOINL void f_gemm_down(FARGS) { MK(); pg8::Gemm g{WSP(bf16_t, WS_ACT), WSP(bf16_t, WS_WD), FF, FF, 0, 0}; pg8::Sched S; S.init(M, D, c.G, c.bid, 1); pg8::EpiResid E{WSP(bf16_t, WS_H), D, WSP(float, WS_RSP1), WSP(unsigned char, WS_XB8)}; pg8::gemm_phase<pg8::EpiResid>(c.lds, g, S, E, c.tid); }
NOINL void f_gdn_prep(FARGS, int l, int it) { MK(); gdn_prep(c, l, it); }
NOINL void f_prep_tok(FARGS, int it) { MK(); prep_tokens(c, it); }
NOINL void f_cfox(FARGS, int l, int it) { MK(); prep_cfox(c, it, l); }
NOINL void f_gdn_scan(FARGS, int it) { MK(); gdn_scan(c, it); }
NOINL void f_idx(FARGS, int b, int q0) { MK(); idx_unit(c, b, q0); }
NOINL void f_attn_fox(FARGS, int l, int b, int h, int q0) { MK(); attn_unit<AT_FOX>(c, l, b, h, q0); }
NOINL void f_attn_ret(FARGS, int l, int b, int h, int q0) { MK(); attn_unit<AT_RET>(c, l, b, h, q0); }
NOINL void f_ret_kv(FARGS, int unit) { MK(); ret_chunk_kv(c, unit); }
NOINL void f_ret_scan(FARGS, int item) { MK(); ret_scan(c, item); }
NOINL void f_attn_dsa(FARGS, int l, int b, int q0) { MK(); attn_unit<AT_DSA>(c, l, b, 0, q0); }
NOINL void f_select(FARGS) { MK(); select_rows(c); }
NOINL void f_gdn_fin(FARGS, int l) { MK(); gdn_finish(c, l); }

__global__ void __launch_bounds__(512, 2) fwd_kernel(Params prm) {
    extern __shared__ __attribute__((aligned(16))) unsigned char lds_raw[];
    LAS unsigned char* lds = (LAS unsigned char*)lds_raw; unsigned char* ws = prm.ws; float* out = prm.out;
    Ctx c = mkctx(ws, out, lds);
    if (c.tid < 16) c.misc[c.tid] = 0u;
    if (c.tid < 21) ((LAS unsigned long long*)(lds + LDS_INTAB))[c.tid] = (unsigned long long)prm.in[c.tid];
    __syncthreads();
    const int lo = prm.ph_lo, hi = prm.ph_hi;
    XcdBarrier bar = xcd_barrier_post(c.ctl + CW_BAR, c.misc + 8);
#define A ws, out, lds
#define LAUNDER() do { asm volatile("" : "+s"(ws), "+s"(out)); unsigned la_ = (unsigned)(size_t)lds; asm volatile("" : "+s"(la_)); lds = (LAS unsigned char*)(size_t)la_; c = mkctx(ws, out, lds); asm volatile("" : "+v"(c.tid)); c.lane = c.tid & 63; } while (0)
#define IN_PH(k) (lo <= (k) && (k) < hi)
#define SEAM(k) do { if (IN_PH(k) && IN_PH((k) + 1)) xcd_barrier(bar); LAUNDER(); } while (0)
    if (IN_PH(0)) f_prologue(A);
    SEAM(0);
    for (int l = 0; l < DEPTH; ++l) {
        const int pb = 1 + PH_PER_LAYER * l;
        if (IN_PH(pb + 1)) f_gemm_in(A);
        SEAM(pb + 1);
        if (IN_PH(pb + 2)) {
            for (;;) { const int it = q_next(c, qid_of(l, 0)); if (it >= 1024) break; f_gdn_prep(A, l, it); }
            LAUNDER();
            for (;;) { const int it = q_next(c, qid_of(l, 9)); if (it >= 512) break; f_ret_kv(A, it); }
            LAUNDER();
            for (;;) { const int it = q_next(c, qid_of(l, 1)); if (it >= 256) break; f_prep_tok(A, it); }
            LAUNDER();
            for (;;) { const int it = q_next(c, qid_of(l, 2)); if (it >= 16) break; f_cfox(A, l, it); }
            LAUNDER();
            __syncthreads();
            f_gemm_dsaq(A);
        }
        SEAM(pb + 2);
        if (IN_PH(pb + 3)) {
            for (;;) { const int it = q_next(c, qid_of(l, 3)); if (it >= 16) break; f_gdn_scan(A, it); }
            LAUNDER();
            for (;;) { const int i = q_next(c, qid_of(l, 4)); if (i >= 512) break; f_idx(A, i & 3, 32 * (127 - (i >> 2))); }
            LAUNDER();
            for (;;) { const int i = q_next(c, qid_of(l, 5)); if (i >= 256) break; f_attn_fox(A, l, (i & 15) >> 2, i & 3, 256 * (15 - (i >> 4))); }
            LAUNDER();
            for (;;) { const int i = q_next(c, qid_of(l, 6)); if (i >= 16) break; f_ret_scan(A, i); }
        }
        SEAM(pb + 3);
        if (IN_PH(pb + 4)) { f_select(A);
            LAUNDER();
            for (;;) { const int i = q_next(c, qid_of(l, 10)); if (i >= 256) break; f_attn_ret(A, l, (i & 15) >> 2, i & 3, 256 * (i >> 4)); } }
        SEAM(pb + 4);
        if (IN_PH(pb + 5)) {
            for (;;) { const int it = q_next(c, qid_of(l, 7)); if (it >= 256) break; f_attn_dsa(A, l, it & 3, 64 * (63 - (it >> 2))); }
            LAUNDER();
            { const int nb = cvt_early_nblk(l); for (;;) { const int it = q_next(c, qid_of(l, 8)); if (it >= nb) break; f_cvt_early(A, l, it); } }
            LAUNDER();
            f_gdn_fin(A, l);
        }
        SEAM(pb + 5);
        if (IN_PH(pb + 6)) f_gemm_merge(A);
        SEAM(pb + 6);
        if (IN_PH(pb + 7)) f_gemm_out(A);
        SEAM(pb + 7);
        if (IN_PH(pb + 9)) f_gemm_gate(A, l);
        SEAM(pb + 9);
        if (IN_PH(pb + 10)) f_gemm_up(A, l);
        SEAM(pb + 10);
        if (IN_PH(pb + 11)) f_gemm_down(A);
        SEAM(pb + 11);
    }
    if (IN_PH(PH_FINAL)) f_final(A);
#undef IN_PH
#undef SEAM
#undef A
}

extern "C" void kernel_launch(void* const* d_in, const int* in_sizes, int n_in, void* d_out, int out_size, void* d_ws, size_t ws_size, hipStream_t stream) {
    static int grid = 0;
    if (grid == 0) {
        if (n_in != 21 || out_size != M * D || ws_size < WS_END) { fprintf(stderr, "kernel_launch: unexpected sizes (n_in %d out %d ws %zu)\n", n_in, out_size, ws_size); grid = -1; return; }
        int dev = 0, cus = 0;
        if (hipGetDevice(&dev) != hipSuccess || hipDeviceGetAttribute(&cus, hipDeviceAttributeMultiprocessorCount, dev) != hipSuccess) { grid = -1; return; }
        if (hipFuncSetAttribute((const void*)fwd_kernel, hipFuncAttributeMaxDynamicSharedMemorySize, LDS_BYTES) != hipSuccess) { fprintf(stderr, "kernel_launch: hipFuncSetAttribute failed\n"); grid = -1; return; }
        int per_cu = 0;
        if (hipOccupancyMaxActiveBlocksPerMultiprocessor(&per_cu, (const void*)fwd_kernel, 512, LDS_BYTES) != hipSuccess || per_cu < 1) { fprintf(stderr, "kernel_launch: occupancy query says %d\n", per_cu); }
        (void)hipGetLastError();
        grid = cus;
    }
    if (grid < 0) return;
    (void)hipMemsetAsync((char*)d_ws + WS_CTL, 0, CTL_BYTES, stream);
    Params p{};
    for (int i = 0; i < 21; ++i) p.in[i] = (const float*)d_in[i];
    p.out = (float*)d_out; p.ws = (unsigned char*)d_ws;
    p.ph_lo = 0; p.ph_hi = N_PHASES;
    hipLaunchKernelGGL(fwd_kernel, dim3(grid), dim3(512), LDS_BYTES, stream, p);
}
```

```cpp
#include <hip/hip_runtime.h>
#include <cstdio>
#include <cstdint>

#define LAS __attribute__((address_space(3)))
typedef unsigned short bf16_t;
typedef short bf16x8 __attribute__((ext_vector_type(8)));
typedef short s16x4 __attribute__((ext_vector_type(4)));
typedef float f32x2 __attribute__((ext_vector_type(2)));
typedef float f32x4 __attribute__((ext_vector_type(4)));
typedef float f32x16 __attribute__((ext_vector_type(16)));
typedef unsigned u32x2 __attribute__((ext_vector_type(2)));
typedef unsigned u32x4 __attribute__((ext_vector_type(4)));
typedef __bf16 hbf2 __attribute__((ext_vector_type(2)));
#define DI __device__ __forceinline__

constexpr int D = 2048, BATCH = 4, SEQ = 4096, DEPTH = 4, M = BATCH * SEQ;
constexpr int NP = 14592, FF = 5632, NSRC = 14556;
constexpr float EPS = 1e-6f;
constexpr int C_RQ = 0, C_RK = 512, C_RV = 1024, C_RG = 1536, C_FQ = 2048, C_FK = 2560, C_FV = 3072, C_GQ = 3584, C_GK = 4096, C_GV = 4608, C_GZ = 5120,
              C_DCQ = 5632, C_DK = 6016, C_DV = 6144, C_IK = 6272, C_IW = 6336, C_FF = 6352, C_GB = 6356, C_GA = 6360, C_GATE = 6400;
__host__ __device__ constexpr int src_col(int j) {
    return j < 2048 ? j : j < 3584 ? 2768 + (j - 2048) : j < 5632 ? 4308 + (j - 3584) : j < 6352 ? 2048 + (j - 5632) : j < 6356 ? 4304 + (j - 6352)
         : j < 6364 ? j : j < 6400 ? -1 : 6364 + (j - 6400);
}
constexpr int O_RET = 0, O_DSA = 512, O_FOX = 1024, O_GDN = 1536;
constexpr int VT_ROWS = 1152, VT_RET = 0, VT_FOX = 512, VT_DSA = 1024;

constexpr size_t MiB = 1u << 20;
constexpr size_t WS_CTL = 0, CTL_BYTES = 256 * 1024;
constexpr size_t WS_ROPE = 1 * MiB;
constexpr size_t WS_BT = 3 * MiB;
constexpr size_t WS_WIN = 4 * MiB;
constexpr size_t WS_WG8 = 30 * MiB;
constexpr size_t WS_WBR = 61 * MiB;
constexpr size_t WS_WOUT = 69 * MiB;
constexpr size_t WS_WDSA = 77 * MiB;
constexpr size_t WS_H = 80 * MiB;
constexpr size_t WS_PROJ = 144 * MiB;
constexpr size_t WS_G = WS_PROJ, WS_ACT = WS_PROJ + 176 * MiB;
constexpr size_t WS_BR = 600 * MiB;
constexpr size_t WS_RQ = 664 * MiB, WS_RK = 680 * MiB;
constexpr int VT_LD = SEQ + 128, SC_LD = SEQ + 64;
constexpr size_t WS_VT = 696 * MiB;
constexpr size_t WS_QD = 734 * MiB;
constexpr size_t WS_SC = 782 * MiB;
constexpr size_t WS_WG = WS_SC, WS_WU = WS_SC + 22 * MiB, WS_WD = WS_SC + 44 * MiB;
constexpr size_t WS_MASK = 1042 * MiB;
constexpr size_t WS_U0 = 1050 * MiB;
constexpr size_t WS_KCUM = 1082 * MiB;
constexpr size_t WS_QDEC = 1098 * MiB;
constexpr size_t WS_KDT = 1114 * MiB;
constexpr size_t WS_QKM = 1130 * MiB;
constexpr size_t WS_OG = 1138 * MiB;
constexpr size_t WS_SMALL = 1170 * MiB;
constexpr size_t WS_CFOX = WS_SMALL, WS_RDSA = WS_SMALL + 256 * 1024, WS_EGL = WS_SMALL + 320 * 1024;
constexpr size_t WS_RSP1 = 1172 * MiB, WS_RSP2 = 1174 * MiB;
constexpr size_t WS_RF = 1176 * MiB;
constexpr size_t WS_XB8 = 1177 * MiB;
constexpr size_t WS_KVT = 1209 * MiB;
constexpr size_t WS_END = 1241 * MiB;
static_assert(WS_VT + (size_t)BATCH * 1152 * VT_LD * 2 <= WS_QD && WS_SC + (size_t)M * SC_LD * 4 <= WS_MASK, "ws map");

constexpr int CW_BAR = 4096;
constexpr int CW_Q = 16384;
constexpr int CW_GF = 32768;

constexpr int LDS_BYTES = 136 * 1024;
constexpr int LDS_MISC = 132 * 1024;

DI float bf2f(bf16_t v) { return __uint_as_float(((unsigned)v) << 16); }
DI unsigned pk2(float lo, float hi) { f32x2 v = {lo, hi}; hbf2 r = __builtin_convertvector(v, hbf2); return __builtin_bit_cast(unsigned, r); }
DI bf16_t f2bf(float f) { return (bf16_t)(pk2(f, 0.f) & 0xffffu); }
DI float lo_bf(unsigned w) { return __uint_as_float(w << 16); }
DI float hi_bf(unsigned w) { return __uint_as_float(w & 0xffff0000u); }
DI bf16x8 pack8(float a0, float a1, float a2, float a3, float a4, float a5, float a6, float a7) {
    u32x4 w = {pk2(a0, a1), pk2(a2, a3), pk2(a4, a5), pk2(a6, a7)}; return __builtin_bit_cast(bf16x8, w);
}
DI float wave_sum(float v) {
#pragma unroll
    for (int o = 1; o < 64; o <<= 1) v += __shfl_xor(v, o);
    return v;
}
DI float sigmoidf_(float x) { return 1.f / (1.f + __expf(-x)); }
DI float siluf_(float x) { return x / (1.f + __expf(-x)); }
typedef int v8i __attribute__((ext_vector_type(8)));
typedef int v4i __attribute__((ext_vector_type(4)));
DI unsigned pk4_fp8(float a, float b, float c_, float d) {
    a = fminf(fmaxf(a, -448.f), 448.f); b = fminf(fmaxf(b, -448.f), 448.f); c_ = fminf(fmaxf(c_, -448.f), 448.f); d = fminf(fmaxf(d, -448.f), 448.f);
    int p = 0; p = __builtin_amdgcn_cvt_pk_fp8_f32(a, b, p, false); p = __builtin_amdgcn_cvt_pk_fp8_f32(c_, d, p, true); return (unsigned)p; }
#define MFMA32(a, b, c) __builtin_amdgcn_mfma_f32_32x32x16_bf16((a), (b), (c), 0, 0, 0)
DI int crow(int r, int hf) { return (r & 3) + 8 * (r >> 2) + 4 * hf; }
DI void rs_factors8(const float* rf_, int row0, int  , float (&rf)[2][4]) {
#pragma unroll
    for (int ai = 0; ai < 2; ++ai)
#pragma unroll
        for (int m = 0; m < 4; ++m) rf[ai][m] = rf_[row0 + ai * 128 + m * 16];
}

#define XB_TMO      128
#define XB_XCNT(j)  (256  + 64 * (j))
#define XB_XSUB(j)  (1280 + 64 * (j))
#define XB_XGEN(j)  (2304 + 64 * (j))
#define XB_TOP      3328
#define XB_TOPGEN   3392
#define XCD_BAR_WORDS 3456
#define XB_SPIN_CAP (1u << 21)
__device__ __forceinline__ unsigned xb_ld(unsigned* p)              { return __hip_atomic_load(p, __ATOMIC_RELAXED, __HIP_MEMORY_SCOPE_AGENT); }
__device__ __forceinline__ unsigned xb_add(unsigned* p, unsigned v) { return __hip_atomic_fetch_add(p, v, __ATOMIC_RELAXED, __HIP_MEMORY_SCOPE_AGENT); }
__device__ __forceinline__ unsigned xb_xcc_id() { return (unsigned)__builtin_amdgcn_s_getreg((3 << 11) | 20) & 0xFu; }
#define XB_SPIN(cond, bar) do { unsigned _sp = 0; while (cond) { __builtin_amdgcn_s_sleep(1); \
    if ((++_sp & 255u) == 0u) { if (xb_ld(&(bar)[XB_TMO])) break; if (_sp > XB_SPIN_CAP) { atomicAdd(&(bar)[XB_TMO], 1u); break; } } } } while (0)
struct XcdBarrier { unsigned* bar; unsigned x; volatile LAS unsigned* st; };
__device__ __forceinline__ XcdBarrier xcd_barrier_post(unsigned* bar, volatile LAS unsigned* st) {
    XcdBarrier b; b.bar = bar; b.x = xb_xcc_id(); b.st = st;
    if (threadIdx.x == 0) (void)xb_add(&bar[XB_XCNT(b.x)], 1u);
    return b;
}
__device__ __forceinline__ void xcd_barrier_complete(unsigned* bar, unsigned x, unsigned& nloc, unsigned& nx) {
    const unsigned G = gridDim.x * gridDim.y * gridDim.z;
    unsigned sum, cnt, mine, sp = 0u;
    for (;;) {
        sum = 0u; cnt = 0u; mine = 0u;
#pragma unroll
        for (unsigned j = 0; j < 16; ++j) { const unsigned c = xb_ld(&bar[XB_XCNT(j)]); sum += c; cnt += (c > 0u) ? 1u : 0u; mine = (j == x) ? c : mine; }
        if (sum == G) break;
        __builtin_amdgcn_s_sleep(1);
        if ((++sp & 255u) == 0u) { if (xb_ld(&bar[XB_TMO])) break; if (sp > XB_SPIN_CAP) { atomicAdd(&bar[XB_TMO], 1u); break; } }
    }
    nloc = mine > 0u ? mine : 1u; nx = cnt > 0u ? cnt : 1u;
}
__device__ __forceinline__ void xcd_barrier(const XcdBarrier& b) {
    asm volatile("s_waitcnt vmcnt(0)" ::: "memory");
    __syncthreads();
    if (threadIdx.x == 0) {
        unsigned* bar = b.bar;
        __builtin_amdgcn_s_waitcnt(0);
        unsigned nloc = b.st[0], nx = b.st[1];
        if (nloc == 0u) { xcd_barrier_complete(bar, b.x, nloc, nx); b.st[0] = nloc; b.st[1] = nx; }
        const unsigned old = xb_add(&bar[XB_XSUB(b.x)], 1u);
        const unsigned gen = old / nloc;
        if (old + 1u == (gen + 1u) * nloc) {
            __builtin_amdgcn_fence(__ATOMIC_RELEASE, "agent");
            asm volatile("s_waitcnt vmcnt(0)" ::: "memory");
            const unsigned og = xb_add(&bar[XB_TOP], 1u);
            const unsigned tg = og / nx;
            if (og + 1u == (tg + 1u) * nx) xb_add(&bar[XB_TOPGEN], 1u);
            else XB_SPIN(xb_ld(&bar[XB_TOPGEN]) == tg, bar);
            __builtin_amdgcn_fence(__ATOMIC_ACQUIRE, "agent");
            xb_add(&bar[XB_XGEN(b.x)], 1u);
            asm volatile("s_waitcnt vmcnt(0)" ::: "memory");
        } else {
            XB_SPIN(xb_ld(&bar[XB_XGEN(b.x)]) == gen, bar);
            __builtin_amdgcn_fence(__ATOMIC_ACQUIRE, "agent");
            asm volatile("s_waitcnt vmcnt(0)" ::: "memory");
        }
    }
    __syncthreads();
}

namespace pg8 {
constexpr int BM = 256, BK = 64, HALF = 128, HTB = HALF * BK * 2, STAGE_BYTES = 8 * HTB, NXCD = 8, WGM = 8;
__host__ __device__ __forceinline__ int lds_byte(int r, int c) { const int st = (r >> 4) * 2 + (c >> 5), rr = r & 15, cc = c & 31, ob = rr * 64 + cc * 2; return st * 1024 + (ob ^ (((ob >> 9) & 1) << 5)); }
__host__ __device__ __forceinline__ void stage_rc(int b, int& R, int& C) { const int st = b / 1024, sb = b % 1024, swz = sb ^ (((sb >> 9) & 1) << 5); R = (st >> 1) * 16 + swz / 64; C = (st & 1) * 32 + (swz % 64) / 2; }
__host__ __device__ __forceinline__ int perm32(int rho) { const int n = rho >> 4, i = rho & 15; return 8 * (i >> 2) + 4 * n + (i & 3); }
struct Unit { int pm, pn, sub; };
struct Gemm { const bf16_t* A; const bf16_t* Bt; int lda, K; size_t subA, subB; };
struct Sched {
    int nM, nN, nwg, G, c, nsub;
    __device__ void init(int M_, int N_, int G_, int c_, int nsub_) { nM = M_ / BM; nN = N_ / BM; nwg = nM * nN; G = G_; c = c_; nsub = nsub_; }
    __device__ bool next(int i, Unit& u) const {
        const int ti = i / nsub; u.sub = i - ti * nsub;
        const long L = (long)ti * G + c; if (L >= nwg) return false;
        int wgid = (int)L; { const int q = nwg / NXCD, r = nwg % NXCD, xcd = wgid % NXCD, off = wgid / NXCD; wgid = (xcd < r ? xcd * (q + 1) : r * (q + 1) + (xcd - r) * q) + off; }
        const int nig = WGM * nN, gid = wgid / nig, fm = gid * WGM, gsz = (nM - fm) < WGM ? (nM - fm) : WGM;
        u.pm = fm + ((wgid % nig) % gsz); u.pn = (wgid % nig) / gsz; return true;
    }
};
template <class E> __device__ __forceinline__ auto unit_begin(const E& e, const Unit& u, int wid, int) -> decltype(e.begin(u, wid), void()) { e.begin(u, wid); }
template <class E> __device__ __forceinline__ void unit_begin(const E&, const Unit&, int, long) {}
template <class Epi, bool ALIGN_EPI = true, bool FP8 = false>
__device__ __forceinline__ void gemm_phase(LAS unsigned char* lds, const Gemm g, const Sched& S, const Epi& E, const int tid) {
    const int wid = __builtin_amdgcn_readfirstlane(tid >> 6), lane = tid & 63, wr = wid >> 2, wc = wid & 3, fr = lane & 15, fq = lane >> 4;
    const int K = g.K, nt = K / BK, lda = g.lda;
    unsigned voffA[2], voffB[2];
#pragma unroll
    for (int i = 0; i < 2; ++i) { int R, C; stage_rc(tid * 16 + i * 8192, R, C); const int Rb = Epi::PERM ? ((R & ~31) + perm32(R & 31)) : R;
        voffA[i] = (unsigned)(R * lda + C) * 2u; voffB[i] = (unsigned)(Rb * K + C) * 2u; }
    const size_t kstep = (size_t)(BK * 2);
    const size_t hstepA = (size_t)HALF * lda * 2, hstepB = (size_t)HALF * K * 2;
    const size_t tstepA = 2 * hstepA, tstepB = 2 * hstepB;
    const unsigned ldsw = (unsigned)wid * 1024u;
    const int aoff = lds_byte(wr * 64 + fr, fq * 8), boff = lds_byte(wc * 32 + fr, fq * 8);
#define PG8_SA(b, h) (((b) * 2 + (h)) * HTB)
#define PG8_SB(b, h) ((4 + (b) * 2 + (h)) * HTB)
#define PG8_STAGE(bufoff, gbase, voff) do { _Pragma("unroll") for (int _i = 0; _i < 2; ++_i) \
        __builtin_amdgcn_global_load_lds((const unsigned*)((const char*)(gbase) + (voff)[_i]), (LAS unsigned*)(lds + (bufoff) + ldsw + _i * 8192), 16, 0, 0); } while (0)
#define PG8_LD8(off) __builtin_shufflevector(*(const LAS v4i*)(lds + (off)), *(const LAS v4i*)(lds + (off) + 1024), 0, 1, 2, 3, 4, 5, 6, 7)
#define PG8_LDA(dst, b, h) do { if constexpr (FP8) { _Pragma("unroll") for (int m = 0; m < 4; ++m) dst##8[m] = PG8_LD8(PG8_SA(b, h) + aoff + m * 2048); } else { \
        _Pragma("unroll") for (int m = 0; m < 4; ++m) _Pragma("unroll") for (int k = 0; k < 2; ++k) dst[m][k] = *(const LAS bf16x8*)(lds + PG8_SA(b, h) + aoff + m * 2048 + k * 1024); } } while (0)
#define PG8_LDB(dst, b, h) do { if constexpr (FP8) { _Pragma("unroll") for (int n = 0; n < 2; ++n) dst##8[n] = PG8_LD8(PG8_SB(b, h) + boff + n * 2048); } else { \
        _Pragma("unroll") for (int n = 0; n < 2; ++n) _Pragma("unroll") for (int k = 0; k < 2; ++k) dst[n][k] = *(const LAS bf16x8*)(lds + PG8_SB(b, h) + boff + n * 2048 + k * 1024); } } while (0)
#define PG8_CAT(x, y) __builtin_shufflevector(__builtin_bit_cast(v4i, x), __builtin_bit_cast(v4i, y), 0, 1, 2, 3, 4, 5, 6, 7)
#define PG8_MMA(ai, bj, At, Bt) do { __builtin_amdgcn_s_setprio(1); _Pragma("unroll") for (int m = 0; m < 4; ++m) _Pragma("unroll") for (int n = 0; n < 2; ++n) { \
        if constexpr (FP8) asm volatile("v_mfma_f32_16x16x128_f8f6f4 %0, %1, %2, %0" : "+v"(acc[ai][bj][m][n]) : "v"(Bt##8[n]), "v"(At##8[m])); \
        else { _Pragma("unroll") for (int k = 0; k < 2; ++k) acc[ai][bj][m][n] = __builtin_amdgcn_mfma_f32_16x16x32_bf16(Bt[n][k], At[m][k], acc[ai][bj][m][n], 0, 0, 0); } } __builtin_amdgcn_s_setprio(0); } while (0)
#define PG8_WAIT_V(n) asm volatile("s_waitcnt vmcnt(" #n ")" ::: "memory")
#define PG8_WAIT_L(n) asm volatile("s_waitcnt lgkmcnt(" #n ")" ::: "memory")
#define PG8_BAR __builtin_amdgcn_s_barrier()
#define PG8_SCHED __builtin_amdgcn_sched_barrier(0)
    Unit cur, nxt; int ui = 0;
    if (!S.next(0, cur)) return;
    f32x4 acc[2][2][4][2];
#pragma unroll
    for (int a = 0; a < 2; ++a)
#pragma unroll
        for (int b = 0; b < 2; ++b)
#pragma unroll
            for (int m = 0; m < 4; ++m)
#pragma unroll
                for (int n = 0; n < 2; ++n) acc[a][b][m][n] = (f32x4){0.f, 0.f, 0.f, 0.f};
    bf16x8 At[4][2], B0[2][2], B1[2][2];
    v8i At8[4], B08[2], B18[2];
    const char* cA = (const char*)g.A + (size_t)cur.pm * tstepA + (size_t)cur.sub * g.subA; const char* cB = (const char*)g.Bt + (size_t)cur.pn * tstepB + (size_t)cur.sub * g.subB;
    PG8_STAGE(PG8_SB(0, 0), cB, voffB); PG8_STAGE(PG8_SB(0, 1), cB + hstepB, voffB); PG8_STAGE(PG8_SA(0, 0), cA, voffA); PG8_STAGE(PG8_SA(0, 1), cA + hstepA, voffA);
    if (wr == 1) PG8_BAR;
    PG8_WAIT_V(2); PG8_BAR;
    PG8_STAGE(PG8_SB(1, 0), cB + kstep, voffB); PG8_STAGE(PG8_SA(1, 0), cA + kstep, voffA); PG8_STAGE(PG8_SB(1, 1), cB + hstepB + kstep, voffB);
    PG8_WAIT_V(6); PG8_BAR;
    for (;;) {
        const bool has_next = S.next(ui + 1, nxt);
        unit_begin(E, cur, wid, 0);
        const char* nA = has_next ? (const char*)g.A + (size_t)nxt.pm * tstepA + (size_t)nxt.sub * g.subA : cA;
        const char* nB = has_next ? (const char*)g.Bt + (size_t)nxt.pn * tstepB + (size_t)nxt.sub * g.subB : cB;
        for (int t = 0; t < nt; t += 2) {
            const bool last = (t == nt - 2);
            const char* a1 = cA + (size_t)(t + 1) * kstep;
            const char* a2 = last ? nA : cA + (size_t)(t + 2) * kstep; const char* b2 = last ? nB : cB + (size_t)(t + 2) * kstep;
            const char* a3 = a2 + kstep; const char* b3 = b2 + kstep;
            PG8_LDB(B0, 0, 0); PG8_LDB(B1, 0, 1); PG8_SCHED; PG8_LDA(At, 0, 0); PG8_STAGE(PG8_SA(1, 1), a1 + hstepA, voffA);
            PG8_WAIT_V(8); PG8_WAIT_L(0); PG8_BAR; PG8_MMA(0, 0, At, B0); PG8_MMA(0, 1, At, B1); PG8_BAR; PG8_SCHED;
            PG8_LDA(At, 0, 1); PG8_STAGE(PG8_SB(0, 0), b2, voffB); PG8_STAGE(PG8_SB(0, 1), b2 + hstepB, voffB); PG8_STAGE(PG8_SA(0, 0), a2, voffA);
            PG8_WAIT_V(8); PG8_WAIT_L(0); PG8_BAR; PG8_MMA(1, 0, At, B0); PG8_MMA(1, 1, At, B1); PG8_BAR; PG8_SCHED;
            PG8_LDB(B0, 1, 0); PG8_LDB(B1, 1, 1); PG8_SCHED; PG8_LDA(At, 1, 0); PG8_STAGE(PG8_SA(0, 1), a2 + hstepA, voffA);
            PG8_WAIT_V(8); PG8_WAIT_L(0); PG8_BAR; PG8_MMA(0, 0, At, B0); PG8_MMA(0, 1, At, B1); PG8_BAR; PG8_SCHED;
            PG8_LDA(At, 1, 1); PG8_STAGE(PG8_SB(1, 0), b3, voffB); PG8_STAGE(PG8_SB(1, 1), b3 + hstepB, voffB); PG8_STAGE(PG8_SA(1, 0), a3, voffA);
            PG8_WAIT_V(8); PG8_WAIT_L(0); PG8_BAR; PG8_MMA(1, 0, At, B0); PG8_MMA(1, 1, At, B1); PG8_BAR; PG8_SCHED;
        }
        if constexpr (ALIGN_EPI) { if (wr == 0) PG8_BAR; }
        if constexpr (FP8) asm volatile("s_nop 15\n\ts_nop 15" ::: "memory");
        E(acc, cur, wr, wc, fr, fq);
        if (!has_next) break;
        if (!(Epi::CHAIN && nxt.sub != 0)) {
#pragma unroll
        for (int a = 0; a < 2; ++a)
#pragma unroll
            for (int b = 0; b < 2; ++b)
#pragma unroll
                for (int m = 0; m < 4; ++m)
#pragma unroll
                    for (int n = 0; n < 2; ++n) acc[a][b][m][n] = (f32x4){0.f, 0.f, 0.f, 0.f};
        }
        cur = nxt; cA = nA; cB = nB; ++ui;
        if constexpr (ALIGN_EPI) { if (wr == 1) PG8_BAR; }
    }
    PG8_WAIT_V(0);
    if constexpr (!ALIGN_EPI) { if (wr == 0) PG8_BAR; }
    PG8_BAR;
#undef PG8_SA
#undef PG8_SB
#undef PG8_STAGE
#undef PG8_LDA
#undef PG8_LD8
#undef PG8_LDB
#undef PG8_MMA
#undef PG8_CAT
#undef PG8_WAIT_V
#undef PG8_WAIT_L
#undef PG8_BAR
#undef PG8_SCHED
}

typedef __attribute__((address_space(1))) unsigned gu32;
template <bool COH>
struct EpiBf16T {
    static constexpr bool PERM = true, CHAIN = false;
    bf16_t* O; int ldc; const float* rs; int sig_pn; float oscale;
    __device__ __forceinline__ void operator()(f32x4 (&acc)[2][2][4][2], const Unit& u, int wr, int wc, int fr, int fq) const {
        const int row0 = u.pm * BM + wr * 64 + fr, col0 = u.pn * BM + wc * 32 + 8 * fq;
        const bool sg = u.pn >= sig_pn;
        const __amdgpu_buffer_rsrc_t rsrc = __builtin_amdgcn_make_buffer_rsrc(O, 0, COH ? (int)((size_t)M * ldc * 2) : 0, 0x00020000);
#pragma unroll
        for (int ai = 0; ai < 2; ++ai) {
            float rf4[4] = {1.f, 1.f, 1.f, 1.f};
            if (rs) {
#pragma unroll
                for (int m = 0; m < 4; ++m) rf4[m] = rs[row0 + ai * HALF + m * 16]; }
#pragma unroll
            for (int m = 0; m < 4; ++m) { const int row = row0 + ai * HALF + m * 16; bf16_t* rowp = O + (size_t)row * ldc + col0;
                const float r = rf4[m] * oscale;
#pragma unroll
                for (int bj = 0; bj < 2; ++bj) { f32x4 v0 = acc[ai][bj][m][0] * r, v1 = acc[ai][bj][m][1] * r;
                    if (sg) {
#pragma unroll
                        for (int q = 0; q < 4; ++q) { v0[q] = __builtin_amdgcn_rcpf(1.f + __expf(-v0[q])); v1[q] = __builtin_amdgcn_rcpf(1.f + __expf(-v1[q])); } }
                    u32x4 w; w.x = pk2(v0[0], v0[1]); w.y = pk2(v0[2], v0[3]); w.z = pk2(v1[0], v1[1]); w.w = pk2(v1[2], v1[3]);
                    if constexpr (COH) __builtin_amdgcn_raw_buffer_store_b128(w, rsrc, (unsigned)(((size_t)row * ldc + col0 + bj * HALF) * 2), 0,   16);
                    else *(u32x4*)(rowp + bj * HALF) = w; } }
        }
    }
};
using EpiBf16 = EpiBf16T<false>;
struct EpiGate8 {
    static constexpr bool PERM = true, CHAIN = false;
    unsigned char* O; size_t ldb; const float* rs; float oscale;
    __device__ __forceinline__ void operator()(f32x4 (&acc)[2][2][4][2], const Unit& u, int wr, int wc, int fr, int fq) const {
        const int row0 = u.pm * BM + wr * 64 + fr, col0 = u.pn * BM + wc * 32 + 8 * fq;
#pragma unroll
        for (int ai = 0; ai < 2; ++ai) {
            float rf4[4];
#pragma unroll
            for (int m = 0; m < 4; ++m) rf4[m] = rs[row0 + ai * HALF + m * 16];
#pragma unroll
            for (int m = 0; m < 4; ++m) { const int row = row0 + ai * HALF + m * 16; unsigned char* rowp = O + (size_t)row * ldb + col0;
                const float r = rf4[m] * oscale;
#pragma unroll
                for (int bj = 0; bj < 2; ++bj) { const f32x4 v0 = acc[ai][bj][m][0] * r, v1 = acc[ai][bj][m][1] * r;
                    unsigned w0 = 0u, w1 = 0u;
#pragma unroll
                    for (int q = 0; q < 4; ++q) {
                        const float s0 = fmaxf(255.f * __builtin_amdgcn_rcpf(1.f + __expf(-v0[q])), 1.f), s1 = fmaxf(255.f * __builtin_amdgcn_rcpf(1.f + __expf(-v1[q])), 1.f);
                        w0 = __builtin_amdgcn_cvt_pk_u8_f32(s0, q, w0); w1 = __builtin_amdgcn_cvt_pk_u8_f32(s1, q, w1); }
                    *(u32x2*)(rowp + bj * HALF) = (u32x2){w0, w1}; } }
        }
    }
};
struct EpiResid {
    static constexpr bool PERM = true, CHAIN = false;
    bf16_t* XB; int ldc; float* RS; unsigned char* XB8;
    __device__ __forceinline__ void operator()(f32x4 (&acc)[2][2][4][2], const Unit& u, int wr, int wc, int fr, int fq) const {
        const int row0 = u.pm * BM + wr * 64 + fr, col0 = u.pn * BM + wc * 32 + 8 * fq;
#pragma unroll
        for (int ai = 0; ai < 2; ++ai) {
            u32x4 xv[4][2];
#pragma unroll
            for (int m = 0; m < 4; ++m)
#pragma unroll
                for (int bj = 0; bj < 2; ++bj) xv[m][bj] = *(const u32x4*)(XB + (size_t)(row0 + ai * HALF + m * 16) * ldc + col0 + bj * HALF);
#pragma unroll
            for (int m = 0; m < 4; ++m) { const int row = row0 + ai * HALF + m * 16; float ss = 0.f;
#pragma unroll
                for (int bj = 0; bj < 2; ++bj) { const u32x4 x = xv[m][bj];
                    const f32x4 y0 = acc[ai][bj][m][0] + (f32x4){lo_bf(x.x), hi_bf(x.x), lo_bf(x.y), hi_bf(x.y)}, y1 = acc[ai][bj][m][1] + (f32x4){lo_bf(x.z), hi_bf(x.z), lo_bf(x.w), hi_bf(x.w)};
                    { u32x4 w; w.x = pk2(y0[0], y0[1]); w.y = pk2(y0[2], y0[3]); w.z = pk2(y1[0], y1[1]); w.w = pk2(y1[2], y1[3]); *(u32x4*)(XB + (size_t)row * ldc + col0 + bj * HALF) = w; }
                    if (XB8) { u32x2 w8; w8.x = pk4_fp8(y0[0], y0[1], y0[2], y0[3]); w8.y = pk4_fp8(y1[0], y1[1], y1[2], y1[3]); *(u32x2*)(XB8 + (size_t)row * ldc + col0 + bj * HALF) = w8; }
                    ss += ((y0[0] * y0[0] + y0[1] * y0[1]) + (y0[2] * y0[2] + y0[3] * y0[3])) + ((y1[0] * y1[0] + y1[1] * y1[1]) + (y1[2] * y1[2] + y1[3] * y1[3])); }
                if (RS) { ss += __shfl_xor(ss, 16); ss += __shfl_xor(ss, 32); if (fq == 0) RS[(size_t)row * 32 + u.pn * 4 + wc] = ss; } }
        }
    }
};
struct EpiUp {
    static constexpr bool PERM = true, CHAIN = false;
    bf16_t* O; const bf16_t* G; const float* cw; const float* cb; const float* rs;
    __device__ __forceinline__ void operator()(f32x4 (&acc)[2][2][4][2], const Unit& u, int wr, int wc, int fr, int fq) const {
        const int row0 = u.pm * BM + wr * 64 + fr, col0 = u.pn * BM + wc * 32 + 8 * fq;
#pragma unroll
        for (int bj = 0; bj < 2; ++bj) {
            const int col = col0 + bj * HALF;
            float w0[8], w1[8], w2[8], bb[8];
#pragma unroll
            for (int e = 0; e < 8; e += 4) { const f32x4 a = *(const f32x4*)(cw + col + e), b = *(const f32x4*)(cw + FF + col + e), c = *(const f32x4*)(cw + 2 * FF + col + e), d = *(const f32x4*)(cb + col + e);
#pragma unroll
                for (int q = 0; q < 4; ++q) { w0[e + q] = a[q]; w1[e + q] = b[q]; w2[e + q] = c[q]; bb[e + q] = d[q]; } }
#pragma unroll
            for (int ai = 0; ai < 2; ++ai) {
                u32x4 g[5]; float rfm[4];
                const int gbase = row0 - fr + ai * HALF;
                const int hb = (gbase & (SEQ - 1)) == 0 ? 0 : (fr >= 14 ? 16 - fr : 1);
                g[4] = *(const u32x4*)(G + (size_t)(gbase - hb) * FF + col);
#pragma unroll
                for (int m = 0; m < 4; ++m) { rfm[m] = rs[row0 + ai * HALF + m * 16]; g[m] = *(const u32x4*)(G + (size_t)(row0 + ai * HALF + m * 16) * FF + col); }
#pragma unroll
                for (int m = 0; m < 4; ++m) {
                    const int row = row0 + ai * HALF + m * 16, t = row & (SEQ - 1);
                    const u32x4 cur = g[m], prv = g[m == 0 ? 4 : m - 1];
                    u32x4 h1, h0;
#pragma unroll
                    for (int q = 0; q < 4; ++q) {
                        const int s1 = __builtin_amdgcn_update_dpp(0, (int)cur[q], 0x111, 0xf, 0xf, false), r1 = __builtin_amdgcn_update_dpp(0, (int)prv[q], 0x121, 0xf, 0xf, false);
                        const int s2 = __builtin_amdgcn_update_dpp(0, (int)cur[q], 0x112, 0xf, 0xf, false), r2 = __builtin_amdgcn_update_dpp(0, (int)prv[q], 0x122, 0xf, 0xf, false);
                        h1[q] = t < 1 ? 0u : (unsigned)(fr < 1 ? r1 : s1); h0[q] = t < 2 ? 0u : (unsigned)(fr < 2 ? r2 : s2); }
                    float r[8];
#pragma unroll
                    for (int q = 0; q < 4; ++q) {
                        const float c0 = w0[2 * q] * lo_bf(h0[q]) + w1[2 * q] * lo_bf(h1[q]) + w2[2 * q] * lo_bf(cur[q]) + bb[2 * q];
                        const float c1 = w0[2 * q + 1] * hi_bf(h0[q]) + w1[2 * q + 1] * hi_bf(h1[q]) + w2[2 * q + 1] * hi_bf(cur[q]) + bb[2 * q + 1];
                        r[2 * q] = siluf_(c0); r[2 * q + 1] = siluf_(c1);
                    }
                    const float rn = rfm[m];
                    const f32x4 v0 = acc[ai][bj][m][0] * rn, v1 = acc[ai][bj][m][1] * rn;
                    u32x4 w; w.x = pk2(r[0] * v0[0], r[1] * v0[1]); w.y = pk2(r[2] * v0[2], r[3] * v0[3]); w.z = pk2(r[4] * v1[0], r[5] * v1[1]); w.w = pk2(r[6] * v1[2], r[7] * v1[3]);
                    *(u32x4*)(O + (size_t)row * FF + col) = w;
                }
            }
        }
    }
};
struct EpiGateRel {
    static constexpr bool PERM = true, CHAIN = false;
    EpiBf16T<true> e; gu32* flags;
    __device__ __forceinline__ void operator()(f32x4 (&acc)[2][2][4][2], const Unit& u, int wr, int wc, int fr, int fq) const {
        e(acc, u, wr, wc, fr, fq);
        asm volatile("s_waitcnt vmcnt(0)" ::: "memory");
        if ((fr | fq) == 0) __hip_atomic_fetch_add(flags + (u.pm * (FF / BM) + u.pn) * 16, 1u, __ATOMIC_RELAXED, __HIP_MEMORY_SCOPE_AGENT);
    }
};
struct EpiUpAcq {
    static constexpr bool PERM = true, CHAIN = false;
    EpiUp e; gu32* flags; unsigned want;
    __device__ __forceinline__ void begin(const Unit& u, int wid) const {
        if (wid != 0) return;
        gu32* f = flags + (u.pm * (FF / BM) + u.pn) * 16;
        gu32* fh = (u.pm & 15) ? f - (FF / BM) * 16 : f;
        unsigned spins = 0;
        while ((unsigned)__builtin_amdgcn_readfirstlane(__hip_atomic_load(f, __ATOMIC_RELAXED, __HIP_MEMORY_SCOPE_AGENT)) < want ||
               (unsigned)__builtin_amdgcn_readfirstlane(__hip_atomic_load(fh, __ATOMIC_RELAXED, __HIP_MEMORY_SCOPE_AGENT)) < want) {
            __builtin_amdgcn_s_sleep(1); if (++spins > (1u << 22)) break; }
        __builtin_amdgcn_fence(__ATOMIC_ACQUIRE, "agent");
        asm volatile("s_waitcnt vmcnt(0)" ::: "memory");
    }
    __device__ __forceinline__ void operator()(f32x4 (&acc)[2][2][4][2], const Unit& u, int wr, int wc, int fr, int fq) const { e(acc, u, wr, wc, fr, fq); }
};
struct EpiMerge {
    static constexpr bool PERM = true, CHAIN = true;
    bf16_t* O; const bf16_t* P;
    __device__ __forceinline__ void operator()(f32x4 (&acc)[2][2][4][2], const Unit& u, int wr, int wc, int fr, int fq) const {
        const int row0 = u.pm * BM + wr * 64 + fr, col0 = u.pn * BM + wc * 32 + 8 * fq, n = u.sub;
#pragma unroll
        for (int ai = 0; ai < 2; ++ai) { constexpr int mb = 0;
            u32x2 ga[4][2], gb[4][2];
#pragma unroll
            for (int m = mb; m < mb + 4; ++m)
#pragma unroll
                for (int bj = 0; bj < 2; ++bj) {
                    const unsigned char* gp = (const unsigned char*)(P + (size_t)(row0 + ai * HALF + m * 16) * NP + C_GATE) + n * D + col0 + bj * HALF;
                    ga[m][bj] = *(const u32x2*)gp; gb[m][bj] = *(const u32x2*)(gp + (n < 3 ? D : 0)); }
#pragma unroll
            for (int m = mb; m < mb + 4; ++m) {
                const int row = row0 + ai * HALF + m * 16;
#pragma unroll
                for (int bj = 0; bj < 2; ++bj) {
                    const int col = col0 + bj * HALF;
                    float f[8];
#pragma unroll
                    for (int q = 0; q < 2; ++q) {
                        const unsigned a = ga[m][bj][q], b = gb[m][bj][q];
                        const float a0 = (float)(a & 255u), a1 = (float)((a >> 8) & 255u), a2 = (float)((a >> 16) & 255u), a3 = (float)(a >> 24);
                        if (n < 3) {
                            f[4 * q] = a0 * __builtin_amdgcn_rcpf((float)(b & 255u)); f[4 * q + 1] = a1 * __builtin_amdgcn_rcpf((float)((b >> 8) & 255u));
                            f[4 * q + 2] = a2 * __builtin_amdgcn_rcpf((float)((b >> 16) & 255u)); f[4 * q + 3] = a3 * __builtin_amdgcn_rcpf((float)(b >> 24));
                        } else { f[4 * q] = a0 * (1.f / 255.f); f[4 * q + 1] = a1 * (1.f / 255.f); f[4 * q + 2] = a2 * (1.f / 255.f); f[4 * q + 3] = a3 * (1.f / 255.f); }
                    }
                    f32x4 v0 = acc[ai][bj][m][0], v1 = acc[ai][bj][m][1];
                    v0[0] *= f[0]; v0[1] *= f[1]; v0[2] *= f[2]; v0[3] *= f[3]; v1[0] *= f[4]; v1[1] *= f[5]; v1[2] *= f[6]; v1[3] *= f[7];
                    if (n < 3) { acc[ai][bj][m][0] = v0; acc[ai][bj][m][1] = v1; }
                    else { u32x4 w; w.x = pk2(v0[0], v0[1]); w.y = pk2(v0[2], v0[3]); w.z = pk2(v1[0], v1[1]); w.w = pk2(v1[2], v1[3]);
                        *(u32x4*)(O + (size_t)row * D + col) = w; }
                }
            }
        }
    }
};
}
struct Params { const float* in[21]; float* out; unsigned char* ws; int ph_lo, ph_hi; };
enum { IN_X = 0, IN_NORM_MIX, IN_W_IN, IN_CQ_NORM, IN_W_UQ, IN_W_QIDX, IN_FOX_BIAS, IN_GDN_CONV, IN_GDN_ALOG, IN_GDN_DT, IN_GDN_NORM, IN_W_BRANCH, IN_W_OUT, IN_REL_BIAS,
       IN_NORM_FFN, IN_W_GATE, IN_W_UP, IN_FFN_CONV, IN_FFN_CONVB, IN_W_DOWN, IN_FINAL_NORM };
struct Ctx {
    LAS unsigned char* lds; volatile LAS unsigned* misc; unsigned* ctl; unsigned char* ws;
    int tid, lane, wave, G, bid;
    const LAS unsigned long long* inl; float* out;
};
#define INP(i) ((const float*)c.inl[(i)])
#define WSP(T, off) ((T*)(c.ws + (off)))

DI int q_next(const Ctx& c, int qid) {
    __syncthreads();
    if (c.tid == 0) c.misc[0] = __hip_atomic_fetch_add(c.ctl + CW_Q + 64 * qid, 1u, __ATOMIC_RELAXED, __HIP_MEMORY_SCOPE_AGENT);
    __syncthreads();
    return (int)c.misc[0];
}

template <bool MAP>
DI void cvt_item(const float* W, int K, int N, bf16_t* WT, int nblk, const float* kscale, LAS float*  , int item, int lane) {
    const int kb = item / nblk, nb = item % nblk, k0 = 64 * kb, n0 = 64 * nb;
    const int n = n0 + lane; const int sc = MAP ? src_col(n) : n;
    const int scc = sc >= 0 ? sc : 0; const float live = sc >= 0 ? 1.f : 0.f;
    const float* src = W + (size_t)k0 * N + scc;
    float v[64];
#pragma unroll
    for (int i = 0; i < 64; ++i) v[i] = src[(size_t)i * N];
    if (kscale) {
#pragma unroll
        for (int i = 0; i < 64; ++i) v[i] *= kscale[k0 + i]; }
    bf16_t* dst = WT + (size_t)n * K + k0;
#pragma unroll
    for (int q = 0; q < 8; ++q) { u32x4 o; o.x = pk2(v[8 * q] * live, v[8 * q + 1] * live); o.y = pk2(v[8 * q + 2] * live, v[8 * q + 3] * live); o.z = pk2(v[8 * q + 4] * live, v[8 * q + 5] * live); o.w = pk2(v[8 * q + 6] * live, v[8 * q + 7] * live);
        *(u32x4*)(dst + 8 * q) = o; }
}
DI void cvt_item_gate8(const float* W, const float* gain, unsigned char* W8, int item, int lane) {
    constexpr int nblk = 8192 / 64; const int kb = item / nblk, nb = item % nblk, k0 = 64 * kb, n = 64 * nb + lane;
    const float* src = W + (size_t)k0 * NSRC + (6364 + n);
    float v[64];
#pragma unroll
    for (int i = 0; i < 64; ++i) v[i] = src[(size_t)i * NSRC];
#pragma unroll
    for (int i = 0; i < 64; ++i) v[i] *= gain[k0 + i] * 128.f;
    unsigned char* dst = W8 + (size_t)n * D + k0;
#pragma unroll
    for (int q = 0; q < 4; ++q) { u32x4 o; o.x = pk4_fp8(v[16 * q], v[16 * q + 1], v[16 * q + 2], v[16 * q + 3]); o.y = pk4_fp8(v[16 * q + 4], v[16 * q + 5], v[16 * q + 6], v[16 * q + 7]);
        o.z = pk4_fp8(v[16 * q + 8], v[16 * q + 9], v[16 * q + 10], v[16 * q + 11]); o.w = pk4_fp8(v[16 * q + 12], v[16 * q + 13], v[16 * q + 14], v[16 * q + 15]); *(u32x4*)(dst + 16 * q) = o; }
}
constexpr int CI_INB = (D / 64) * (C_GATE / 64), CI_ING = (D / 64) * (8192 / 64), CI_IN = CI_INB + CI_ING, CI_BR = (512 / 64) * (D / 64), CI_OUT = (D / 64) * (D / 64), CI_UQ = (384 / 64) * (512 / 64), CI_QI = (384 / 64) * (1024 / 64);
constexpr int CI_G = (D / 64) * (FF / 64), CI_D = (FF / 64) * (D / 64);
constexpr int CI_FFN = 2 * CI_G + CI_D, CI_EARLY_MIX = CI_IN + CI_UQ + CI_QI, CI_LATE = 4 * CI_BR + CI_OUT;
DI void cvt_ffn_item(const Ctx& c, int l, int r, LAS float* scr) {
    const float* wg = INP(IN_W_GATE) + (size_t)l * D * FF; const float* wu = INP(IN_W_UP) + (size_t)l * D * FF; const float* wd = INP(IN_W_DOWN) + (size_t)l * FF * D;
    const float* gf = INP(IN_NORM_FFN) + (size_t)l * D;
    if (r < CI_G) { cvt_item<false>(wg, D, FF, WSP(bf16_t, WS_WG), FF / 64, gf, scr, r, c.lane); return; } r -= CI_G;
    if (r < CI_G) { cvt_item<false>(wu, D, FF, WSP(bf16_t, WS_WU), FF / 64, gf, scr, r, c.lane); return; } r -= CI_G;
    cvt_item<false>(wd, FF, D, WSP(bf16_t, WS_WD), D / 64, nullptr, scr, r, c.lane);
}
DI void cvt_early_mix_item(const Ctx& c, int l, int r, LAS float* scr) {
    const float* w_in = INP(IN_W_IN) + (size_t)l * D * NSRC; const float* w_uq = INP(IN_W_UQ) + (size_t)l * 384 * 512; const float* w_qi = INP(IN_W_QIDX) + (size_t)l * 384 * 1024;
    const float* cqg = INP(IN_CQ_NORM) + (size_t)l * 384;
    if (r < CI_INB) { cvt_item<true>(w_in, D, NSRC, WSP(bf16_t, WS_WIN), C_GATE / 64, INP(IN_NORM_MIX) + (size_t)l * D, scr, r, c.lane); return; } r -= CI_INB;
    if (r < CI_ING) { cvt_item_gate8(w_in, INP(IN_NORM_MIX) + (size_t)l * D, WSP(unsigned char, WS_WG8), r, c.lane); return; } r -= CI_ING;
    if (r < CI_UQ) { cvt_item<false>(w_uq, 384, 512, WSP(bf16_t, WS_WDSA), 512 / 64, cqg, scr, r, c.lane); return; } r -= CI_UQ;
    cvt_item<false>(w_qi, 384, 1024, WSP(bf16_t, WS_WDSA) + (size_t)512 * 384, 1024 / 64, cqg, scr, r, c.lane);
}
DI void cvt_late_item(const Ctx& c, int l, int r, LAS float* scr) {
    const float* w_br = INP(IN_W_BRANCH) + (size_t)l * 4 * 512 * D; const float* w_out = INP(IN_W_OUT) + (size_t)l * D * D;
    if (r < 4 * CI_BR) { const int n = r / CI_BR; cvt_item<false>(w_br + (size_t)n * 512 * D, 512, D, WSP(bf16_t, WS_WBR) + (size_t)n * D * 512, D / 64, nullptr, scr, r % CI_BR, c.lane); return; } r -= 4 * CI_BR;
    cvt_item<false>(w_out, D, D, WSP(bf16_t, WS_WOUT), D / 64, nullptr, scr, r, c.lane);
}
DI int cvt_early_nblk(int l) { return (CI_FFN + (l + 1 < DEPTH ? CI_EARLY_MIX : 0) + 31) / 32; }
DI void cvt_early_block(const Ctx& c, int l, int blk) {
    LAS float* scr = (LAS float*)(c.lds + c.wave * 16384);
    const int tot = CI_FFN + (l + 1 < DEPTH ? CI_EARLY_MIX : 0);
    __syncthreads();
    for (int k = 0; k < 4; ++k) { const int it = blk * 32 + c.wave * 4 + k; if (it >= tot) break;
        if (it < CI_FFN) cvt_ffn_item(c, l, it, scr); else cvt_early_mix_item(c, l + 1, it - CI_FFN, scr); }
    __syncthreads();
}
DI void cvt_late_all(const Ctx& c, int l) {
    LAS float* scr = (LAS float*)(c.lds + c.wave * 16384);
    const int gw = c.bid * 8 + c.wave, NGW = c.G * 8;
    for (int it = gw; it < CI_LATE; it += NGW) cvt_late_item(c, l, it, scr);
}
DI void cvt_mixer0(const Ctx& c) {
    LAS float* scr = (LAS float*)(c.lds + c.wave * 16384);
    const int gw = c.bid * 8 + c.wave, NGW = c.G * 8;
    for (int it = gw; it < CI_EARLY_MIX + CI_LATE; it += NGW) { if (it < CI_EARLY_MIX) cvt_early_mix_item(c, 0, it, scr); else cvt_late_item(c, 0, it - CI_EARLY_MIX, scr); }
}
DI void make_tables(const Ctx& c) {
    float* cs = WSP(float, WS_ROPE); float* sn = cs + SEQ * 64;
    for (int e = c.bid * 512 + c.tid; e < SEQ * 64; e += c.G * 512) {
        const int pos = e >> 6, i = e & 63;
        const float inv = 1.f / exp2f((float)i * (13.287712379549449f / 64.f));
        const float ang = (float)pos * inv;
        cs[e] = cosf(ang); sn[e] = sinf(ang);
    }
    if (c.bid == 0) {
        float* bt = WSP(float, WS_BT); const float* rb = INP(IN_REL_BIAS);
        for (int e = c.tid; e < 4 * 128 + 4; e += 512) {
            int h, rel; if (e < 512) { h = e >> 7; rel = e & 127; } else { h = e - 512; rel = 128; }
            int bk;
            if (rel < 16) bk = rel; else { const float lf = logf((float)rel / 16.f) / 2.0794415416798357f * 16.f; bk = 16 + (int)lf; if (bk > 31) bk = 31; }
            bt[e] = rb[bk * 4 + h];
        }
    }
}

DI void rmsnorm_rows(const Ctx& c, const float* x, const float* gain, bf16_t* dst, float* copy) {
    const int gw = c.bid * 8 + c.wave, NGW = c.G * 8;
    f32x4 gv[8];
#pragma unroll
    for (int j = 0; j < 8; ++j) gv[j] = *((const f32x4*)gain + c.lane + 64 * j);
    for (int m = gw; m < M; m += NGW) {
        const f32x4* xr = (const f32x4*)(x + (size_t)m * D) + c.lane;
        f32x4 v[8]; float s = 0.f;
#pragma unroll
        for (int j = 0; j < 8; ++j) { v[j] = xr[64 * j]; s += (v[j].x * v[j].x + v[j].y * v[j].y) + (v[j].z * v[j].z + v[j].w * v[j].w); }
        const float r = rsqrtf(wave_sum(s) * (1.f / D) + EPS);
        u32x2* o = (u32x2*)(dst + (size_t)m * D) + c.lane;
#pragma unroll
        for (int j = 0; j < 8; ++j) { u32x2 w; w.x = pk2(v[j].x * r * gv[j].x, v[j].y * r * gv[j].y); w.y = pk2(v[j].z * r * gv[j].z, v[j].w * r * gv[j].w); o[64 * j] = w; }
        if (copy) { f32x4* cp = (f32x4*)(copy + (size_t)m * D) + c.lane;
#pragma unroll
            for (int j = 0; j < 8; ++j) cp[64 * j] = v[j]; }
    }
}
DI void x0_rows(const Ctx& c, const float* x, bf16_t* xb, float* rs, unsigned char* xb8) {
    const int gw = c.bid * 8 + c.wave, NGW = c.G * 8;
    for (int m = gw; m < M; m += NGW) {
        const f32x4* xr = (const f32x4*)(x + (size_t)m * D) + c.lane;
        f32x4 v[8]; float s = 0.f;
#pragma unroll
        for (int j = 0; j < 8; ++j) { v[j] = xr[64 * j]; s += (v[j].x * v[j].x + v[j].y * v[j].y) + (v[j].z * v[j].z + v[j].w * v[j].w); }
        s = wave_sum(s); if (c.lane < 32) rs[(size_t)m * 32 + c.lane] = c.lane == 0 ? s : 0.f;
        u32x2* o = (u32x2*)(xb + (size_t)m * D) + c.lane;
#pragma unroll
        for (int j = 0; j < 8; ++j) { u32x2 w; w.x = pk2(v[j].x, v[j].y); w.y = pk2(v[j].z, v[j].w); o[64 * j] = w;
            ((unsigned*)(xb8 + (size_t)m * D))[c.lane + 64 * j] = pk4_fp8(v[j].x, v[j].y, v[j].z, v[j].w); }
    }
}
DI void row_factors(const Ctx& c, const float* rsp, float* rf) {
    for (int row = c.bid * 512 + c.tid; row < M; row += c.G * 512) {
        const f32x4* p = (const f32x4*)(rsp + (size_t)row * 32); float s = 0.f;
#pragma unroll
        for (int q = 0; q < 8; ++q) { const f32x4 v = p[q]; s += (v[0] + v[1]) + (v[2] + v[3]); }
        rf[row] = rsqrtf(s * (1.f / D) + EPS);
    }
}
template <class SchedT>
DI void row_factors_units(const Ctx& c, const float* rsp, float* rf, const SchedT& S, int& last_pm) {
    pg8::Unit u;
    for (int i = 0; S.next(i, u); ++i) {
        if (u.pm == last_pm) continue;
        last_pm = u.pm;
        const int row = u.pm * 256 + (c.tid >> 1);
        const f32x4* p = (const f32x4*)(rsp + (size_t)row * 32 + 16 * (c.tid & 1)); float s = 0.f;
#pragma unroll
        for (int q = 0; q < 4; ++q) { const f32x4 v = p[q]; s += (v[0] + v[1]) + (v[2] + v[3]); }
        s += __shfl_xor(s, 1);
        if (!(c.tid & 1)) rf[row] = rsqrtf(s * (1.f / D) + EPS);
    }
    __syncthreads();
}
DI void final_norm(const Ctx& c, float* x, const float* gain, const float fac = 1.f) {
    const int gw = c.bid * 8 + c.wave, NGW = c.G * 8;
    f32x4 gv[8];
#pragma unroll
    for (int j = 0; j < 8; ++j) gv[j] = *((const f32x4*)gain + c.lane + 64 * j);
    for (int m = gw; m < M; m += NGW) {
        f32x4* xr = (f32x4*)(x + (size_t)m * D) + c.lane;
        f32x4 v[8]; float s = 0.f;
#pragma unroll
        for (int j = 0; j < 8; ++j) { v[j] = xr[64 * j]; s += (v[j].x * v[j].x + v[j].y * v[j].y) + (v[j].z * v[j].z + v[j].w * v[j].w); }
        const float r = rsqrtf(wave_sum(s) * (1.f / D) + EPS) * fac;
#pragma unroll
        for (int j = 0; j < 8; ++j) xr[64 * j] = v[j] * r * gv[j];
    }
}
DI void final_norm_bf(const Ctx& c, const bf16_t* xb, float* out, const float* gain) {
    const int gw = c.bid * 8 + c.wave, NGW = c.G * 8;
    f32x4 gv[8];
#pragma unroll
    for (int j = 0; j < 8; ++j) gv[j] = *((const f32x4*)gain + c.lane + 64 * j);
    for (int m = gw; m < M; m += NGW) {
        const u32x2* xr = (const u32x2*)(xb + (size_t)m * D) + c.lane;
        f32x4 v[8]; float s = 0.f;
#pragma unroll
        for (int j = 0; j < 8; ++j) { const u32x2 w = xr[64 * j]; v[j] = (f32x4){lo_bf(w.x), hi_bf(w.x), lo_bf(w.y), hi_bf(w.y)}; s += (v[j].x * v[j].x + v[j].y * v[j].y) + (v[j].z * v[j].z + v[j].w * v[j].w); }
        const float r = rsqrtf(wave_sum(s) * (1.f / D) + EPS);
        f32x4* o = (f32x4*)(out + (size_t)m * D) + c.lane;
#pragma unroll
        for (int j = 0; j < 8; ++j) o[64 * j] = v[j] * r * gv[j];
    }
}

DI void prep_tokens(const Ctx& c, int item) {
    const int row0 = item * 64, b = row0 / SEQ, s0 = row0 % SEQ;
    const bf16_t* P = WSP(bf16_t, WS_PROJ);
    { const float* cs = WSP(float, WS_ROPE); const float* sn = cs + SEQ * 64; bf16_t* RQ = WSP(bf16_t, WS_RQ); bf16_t* RK = WSP(bf16_t, WS_RK);
#pragma unroll 2
      for (int k = 0; k < 8; ++k) { const int e = c.tid + 512 * k;
        const int i8 = e & 7, head = (e >> 3) & 3, which = (e >> 5) & 1, tok = e >> 6;
        const int row = row0 + tok, pos = s0 + tok;
        const bf16_t* src = P + (size_t)row * NP + (which ? C_RK : C_RQ) + head * 128 + 8 * i8;
        const u32x4 a = *(const u32x4*)src, bq = *(const u32x4*)(src + 64);
        const f32x4 c0 = *(const f32x4*)(cs + pos * 64 + 8 * i8), c1 = *(const f32x4*)(cs + pos * 64 + 8 * i8 + 4), s0v = *(const f32x4*)(sn + pos * 64 + 8 * i8), s1v = *(const f32x4*)(sn + pos * 64 + 8 * i8 + 4);
        float x1[8], x2[8], co[8], si[8];
#pragma unroll
        for (int q = 0; q < 4; ++q) { x1[2 * q] = lo_bf(a[q]); x1[2 * q + 1] = hi_bf(a[q]); x2[2 * q] = lo_bf(bq[q]); x2[2 * q + 1] = hi_bf(bq[q]); co[q] = c0[q]; co[4 + q] = c1[q]; si[q] = s0v[q]; si[4 + q] = s1v[q]; }
        u32x4 o1, o2;
#pragma unroll
        for (int q = 0; q < 4; ++q) { o1[q] = pk2(x1[2 * q] * co[2 * q] - x2[2 * q] * si[2 * q], x1[2 * q + 1] * co[2 * q + 1] - x2[2 * q + 1] * si[2 * q + 1]);
            o2[q] = pk2(x1[2 * q] * si[2 * q] + x2[2 * q] * co[2 * q], x1[2 * q + 1] * si[2 * q + 1] + x2[2 * q + 1] * co[2 * q + 1]); }
        bf16_t* dst = (which ? RK : RQ) + (size_t)row * 512 + head * 128 + 8 * i8;
        *(u32x4*)dst = o1; *(u32x4*)(dst + 64) = o2;
      } }
    { const int tok = c.tid >> 3, part = c.tid & 7;
      const bf16_t* src = P + (size_t)(row0 + tok) * NP + C_DCQ + part * 48; float s = 0.f;
#pragma unroll
      for (int j = 0; j < 6; ++j) { const u32x4 w = *(const u32x4*)(src + 8 * j);
#pragma unroll
          for (int q = 0; q < 4; ++q) { const float a = lo_bf(w[q]), bb = hi_bf(w[q]); s += a * a + bb * bb; } }
      s += __shfl_xor(s, 1); s += __shfl_xor(s, 2); s += __shfl_xor(s, 4);
      if (part == 0) WSP(float, WS_RDSA)[row0 + tok] = rsqrtf(s * (1.f / 384.f) + EPS); }
    LAS bf16_t* tile = (LAS bf16_t*)c.lds;
    bf16_t* VT = WSP(bf16_t, WS_VT);
#pragma unroll
    for (int rd = 0; rd < 2; ++rd) {
        const int nch = rd == 0 ? 5 : 4, ch0 = rd == 0 ? 0 : 5;
        u32x4 w[10];
#pragma unroll
        for (int q = 0; q < 10; ++q) if (q < 2 * nch) { const int chn = ch0 + (q >> 1); const int scol = chn < 4 ? C_RV + 128 * chn : chn < 8 ? C_FV + 128 * (chn - 4) : C_DV;
            const int idx = c.tid + 512 * (q & 1), r = idx >> 4, ch = idx & 15; w[q] = *(const u32x4*)(P + (size_t)(row0 + r) * NP + scol + ch * 8); }
        __syncthreads();
#pragma unroll
        for (int q = 0; q < 10; ++q) if (q < 2 * nch) { const int idx = c.tid + 512 * (q & 1), r = idx >> 4, ch = idx & 15;
            LAS unsigned* d = (LAS unsigned*)(tile + r * 642 + (q >> 1) * 128 + ch * 8); d[0] = w[q].x; d[1] = w[q].y; d[2] = w[q].z; d[3] = w[q].w; }
        __syncthreads();
#pragma unroll
        for (int q = 0; q < 10; ++q) if (q < 2 * nch) { const int chn = ch0 + (q >> 1); const int vrow = chn < 4 ? VT_RET + 128 * chn : chn < 8 ? VT_FOX + 128 * (chn - 4) : VT_DSA;
            const int idx = c.tid + 512 * (q & 1), col = idx >> 3, tg = idx & 7;
            unsigned short v[8];
#pragma unroll
            for (int e = 0; e < 8; ++e) v[e] = tile[(8 * tg + e) * 642 + (q >> 1) * 128 + col];
            u32x4 o; o.x = v[0] | ((unsigned)v[1] << 16); o.y = v[2] | ((unsigned)v[3] << 16); o.z = v[4] | ((unsigned)v[5] << 16); o.w = v[6] | ((unsigned)v[7] << 16);
            *(u32x4*)(VT + ((size_t)(b * VT_ROWS + vrow + col)) * VT_LD + s0 + 8 * tg) = o; }
    }
    __syncthreads();
}
DI void prep_cfox(const Ctx& c, int item, int l) {
    const int b = item >> 2, h = item & 3;
    const bf16_t* P = WSP(bf16_t, WS_PROJ); const float fb = INP(IN_FOX_BIAS)[l * 4 + h];
    float v[8]; float run = 0.f;
#pragma unroll
    for (int j = 0; j < 8; ++j) { const float x = bf2f(P[(size_t)(b * SEQ + c.tid * 8 + j) * NP + C_FF + h]) + fb;
        const float ls = fminf(x, 0.f) - __logf(1.f + __expf(-fabsf(x))); run += ls; v[j] = run; }
    float tot = run;
#pragma unroll
    for (int o = 1; o < 64; o <<= 1) { const float t = __shfl_up(tot, o); if (c.lane >= o) tot += t; }
    LAS float* wt = (LAS float*)c.lds;
    __syncthreads();
    if (c.lane == 63) wt[c.wave] = tot;
    __syncthreads();
    float pre = tot - run;
    for (int w = 0; w < c.wave; ++w) pre += wt[w];
    float* dst = WSP(float, WS_CFOX) + (size_t)(b * 4 + h) * SEQ + c.tid * 8;
#pragma unroll
    for (int j = 0; j < 8; ++j) dst[j] = pre + v[j];
    __syncthreads();
}
DI void gdn_finish(const Ctx& c, int l) {
    const int gw = c.bid * 8 + c.wave, NGW = c.G * 8;
    const float* OG = WSP(float, WS_OG); const bf16_t* P = WSP(bf16_t, WS_PROJ); bf16_t* BR = WSP(bf16_t, WS_BR);
    const float* ng = INP(IN_GDN_NORM) + l * 128 + ((8 * c.lane) & 127);
    const f32x4 g0 = *(const f32x4*)ng, g1 = *(const f32x4*)(ng + 4);
    for (int m = gw; m < M; m += NGW) {
        const f32x4 a = *(const f32x4*)(OG + (size_t)m * 512 + 8 * c.lane), bq = *(const f32x4*)(OG + (size_t)m * 512 + 8 * c.lane + 4);
        float s = (a.x * a.x + a.y * a.y) + (a.z * a.z + a.w * a.w) + (bq.x * bq.x + bq.y * bq.y) + (bq.z * bq.z + bq.w * bq.w);
        s += __shfl_xor(s, 1); s += __shfl_xor(s, 2); s += __shfl_xor(s, 4); s += __shfl_xor(s, 8);
        const float r = rsqrtf(s * (1.f / 128.f) + EPS);
        const u32x4 z = *(const u32x4*)(P + (size_t)m * NP + C_GZ + 8 * c.lane);
        u32x4 w;
        w.x = pk2(a.x * r * g0.x * siluf_(lo_bf(z.x)), a.y * r * g0.y * siluf_(hi_bf(z.x)));
        w.y = pk2(a.z * r * g0.z * siluf_(lo_bf(z.y)), a.w * r * g0.w * siluf_(hi_bf(z.y)));
        w.z = pk2(bq.x * r * g1.x * siluf_(lo_bf(z.z)), bq.y * r * g1.y * siluf_(hi_bf(z.z)));
        w.w = pk2(bq.z * r * g1.z * siluf_(lo_bf(z.w)), bq.w * r * g1.w * siluf_(hi_bf(z.w)));
        *(u32x4*)(BR + (size_t)m * D + O_GDN + 8 * c.lane) = w;
    }
}
enum { AT_FOX = 0, AT_RET = 1, AT_DSA = 2 };
constexpr int AT_KSTR = 272, AT_VSTR = 136;
constexpr int AT_KBYTES = 64 * AT_KSTR, AT_VBYTES = 128 * AT_VSTR;
constexpr int AT_BUF = AT_KBYTES + AT_VBYTES + 256;
constexpr int AT_TAB = 2 * AT_BUF;
constexpr float SM_SCALE = 0.08838834764831845f, LOG2E = 1.4426950408889634f;

template <int MODE>
DI void attn_unit(const Ctx& c, int l, int b, int hh, int q0) {
    LAS unsigned char* lds = c.lds;
    const int tid = c.tid, w = c.wave, lane = c.lane, l31 = lane & 31, hf = lane >> 5;
    const int head = (MODE == AT_DSA) ? (w >> 1) : hh;
    const int qw0 = q0 + ((MODE == AT_DSA) ? 32 * (w & 1) : 32 * w);
    const int t = qw0 + l31;
    constexpr int QR = (MODE == AT_DSA) ? 64 : 256;
    const int nkt = (q0 + QR) / 64;
    const bf16_t* P = WSP(bf16_t, WS_PROJ);
    const bf16_t* Qb; int ldq; const bf16_t* Kb; int ldk; int vrow0, ocol;
    if (MODE == AT_FOX) { Qb = P + C_FQ + head * 128; ldq = NP; Kb = P + C_FK + head * 128; ldk = NP; vrow0 = VT_FOX + head * 128; ocol = O_FOX + head * 128; }
    else if (MODE == AT_RET) { Qb = WSP(bf16_t, WS_RQ) + head * 128; ldq = 512; Kb = WSP(bf16_t, WS_RK) + head * 128; ldk = 512; vrow0 = VT_RET + head * 128; ocol = O_RET + head * 128; }
    else { Qb = WSP(bf16_t, WS_QD) + head * 128; ldq = 1536; Kb = P + C_DK; ldk = NP; vrow0 = VT_DSA; ocol = O_DSA + head * 128; }
    const bf16_t* VTb = WSP(bf16_t, WS_VT) + (size_t)(b * VT_ROWS + vrow0) * VT_LD;
    const float* cf = WSP(float, WS_CFOX) + (size_t)(b * 4 + head) * SEQ;

    bf16x8 qf[8];
    { const bf16_t* qp = Qb + (size_t)(b * SEQ + t) * ldq + 8 * hf;
#pragma unroll
      for (int s = 0; s < 8; ++s) qf[s] = *(const bf16x8*)(qp + 16 * s); }
    float xscale = SM_SCALE * LOG2E, cq = 0.f, lg = 0.f;
    if (MODE == AT_DSA) xscale = SM_SCALE * LOG2E * WSP(float, WS_RDSA)[b * SEQ + t];
    if (MODE == AT_RET) { lg = log2f(1.f - exp2f(-5.f - (float)head)); xscale = SM_SCALE; }
    const unsigned long long* mrow = WSP(unsigned long long, WS_MASK) + (size_t)(b * SEQ + t) * 64;
    LAS float* tab = (LAS float*)(lds + AT_TAB);
    __syncthreads();
    if (MODE == AT_RET) { if (tid < 64) tab[tid] = exp2f(lg * (float)(63 - tid)); }
    if (MODE == AT_DSA) { const float* bt = WSP(float, WS_BT); for (int e = tid; e < 516; e += 512) tab[e] = bt[e] * LOG2E; }

    u32x4 kreg[2], vreg[2]; float creg = 0.f; unsigned long long mreg = 0ull, mcur = 0ull;
    auto issue = [&](int j) {
#pragma unroll
        for (int p = 0; p < 2; ++p) { const int idx = tid + 512 * p;
            kreg[p] = *(const u32x4*)(Kb + (size_t)(b * SEQ + 64 * j + (idx >> 4)) * ldk + (idx & 15) * 8);
            vreg[p] = *(const u32x4*)(VTb + (size_t)(idx >> 3) * VT_LD + 64 * j + (idx & 7) * 8); }
        if (MODE == AT_FOX) creg = cf[64 * j + (tid & 63)];
        if (MODE == AT_DSA) mreg = mrow[j];
    };
    auto commit = [&](int buf) {
        LAS unsigned char* kb = lds + buf * AT_BUF; LAS unsigned char* vb = kb + AT_KBYTES;
#pragma unroll
        for (int p = 0; p < 2; ++p) { const int idx = tid + 512 * p;
            *(LAS u32x4*)(kb + (idx >> 4) * AT_KSTR + (idx & 15) * 16) = kreg[p];
            LAS u32x2* vd = (LAS u32x2*)(vb + (idx >> 3) * AT_VSTR + (idx & 7) * 16);
            vd[0] = (u32x2){vreg[p].x, vreg[p].y}; vd[1] = (u32x2){vreg[p].z, vreg[p].w}; }
        if (MODE == AT_FOX) { if (tid < 64) ((LAS float*)(vb + AT_VBYTES))[tid] = creg * LOG2E; }
        mcur = mreg;
    };
    f32x16 o[4];
#pragma unroll
    for (int i = 0; i < 4; ++i)
#pragma unroll
        for (int r = 0; r < 16; ++r) o[i][r] = 0.f;
    float mrun = -1e30f, lsum = 0.f;

    const int j0 = (MODE == AT_RET) ? q0 / 64 : 0;
    const int cst = q0 + 128 * (w >> 2);
    issue(j0); commit(j0 & 1);
    __syncthreads();
    for (int j = j0; j < nkt; ++j) {
        const unsigned long long mtile = mcur;
        if (j + 1 < nkt) issue(j + 1);
        if (64 * j <= qw0 + 31 && (MODE != AT_RET || 64 * j >= cst)) {
            LAS unsigned char* kb = lds + (j & 1) * AT_BUF; LAS unsigned char* vb = kb + AT_KBYTES;
            f32x16 s0, s1;
#pragma unroll
            for (int r = 0; r < 16; ++r) { s0[r] = 0.f; s1[r] = 0.f; }
            constexpr int KBATCH = 4;
            const LAS unsigned char* kp0 = kb + l31 * AT_KSTR + 16 * hf;
#pragma unroll
            for (int sb = 0; sb < 8; sb += KBATCH) {
                bf16x8 ka[KBATCH], kc[KBATCH];
#pragma unroll
                for (int s = 0; s < KBATCH; ++s) { ka[s] = *(const LAS bf16x8*)(kp0 + 32 * (sb + s)); kc[s] = *(const LAS bf16x8*)(kp0 + 32 * AT_KSTR + 32 * (sb + s)); }
                __builtin_amdgcn_sched_barrier(0);
#pragma unroll
                for (int s = 0; s < KBATCH; ++s) { s0 = MFMA32(ka[s], qf[sb + s], s0); s1 = MFMA32(kc[s], qf[sb + s], s1); }
                __builtin_amdgcn_sched_barrier(0);
            }
            const LAS unsigned char* vp0 = vb + l31 * AT_VSTR + 8 * hf;
            bf16x8 va[8];
            if (MODE != AT_DSA) {
#pragma unroll
            for (int dt = 0; dt < 2; ++dt)
#pragma unroll
                for (int ks = 0; ks < 4; ++ks) { const LAS unsigned char* vp = vp0 + 32 * dt * AT_VSTR + 32 * ks;
                    va[4 * dt + ks] = __builtin_shufflevector(*(const LAS s16x4*)vp, *(const LAS s16x4*)(vp + 16), 0, 1, 2, 3, 4, 5, 6, 7); }
            __builtin_amdgcn_sched_barrier(0); }
            const int kbase = 64 * j;
            const bool diag = (kbase + 63 > qw0);
            if (MODE == AT_RET) {
                const float rowf = xscale * __builtin_amdgcn_exp2f(lg * (float)(t - kbase - 63));
#pragma unroll
                for (int g = 0; g < 4; ++g) {
                    const f32x4 c0 = *(const LAS f32x4*)(tab + 8 * g + 4 * hf), c1 = *(const LAS f32x4*)(tab + 32 + 8 * g + 4 * hf);
#pragma unroll
                    for (int q = 0; q < 4; ++q) { const int r = 4 * g + q;
                        s0[r] = s0[r] * (rowf * c0[q]); s1[r] = s1[r] * (rowf * c1[q]); }
                }
                if (diag) {
#pragma unroll
                    for (int r = 0; r < 16; ++r) { const int key = kbase + crow(r, hf); if (key > t) s0[r] = 0.f; if (key + 32 > t) s1[r] = 0.f; } }
            } else {
                float mloc = -__builtin_inff();
                if (MODE == AT_FOX) {
                    const LAS float* ck = (const LAS float*)(vb + AT_VBYTES);
#pragma unroll
                    for (int g = 0; g < 4; ++g) {
                        const f32x4 c0 = *(const LAS f32x4*)(ck + 8 * g + 4 * hf), c1 = *(const LAS f32x4*)(ck + 32 + 8 * g + 4 * hf);
#pragma unroll
                        for (int q = 0; q < 4; ++q) { const int r = 4 * g + q; s0[r] = fmaf(s0[r], xscale, -c0[q]); s1[r] = fmaf(s1[r], xscale, -c1[q]); }
                    }
                    if (diag) {
#pragma unroll
                        for (int r = 0; r < 16; ++r) { const int key = kbase + crow(r, hf); if (key > t) s0[r] = -__builtin_inff(); if (key + 32 > t) s1[r] = -__builtin_inff(); } }
#pragma unroll
                    for (int r = 0; r < 16; ++r) mloc = fmaxf(mloc, fmaxf(s0[r], s1[r]));
                } else {
                    const unsigned long long mw = mtile; const int mlo = (int)(unsigned)mw, mhi = (int)(unsigned)(mw >> 32);
                    const float bconst = tab[512 + head]; const bool btab = (qw0 - (kbase + 63) < 113);
#pragma unroll
                    for (int r = 0; r < 16; ++r) { const int kk = crow(r, hf); const int key = kbase + kk;
                        float b0 = bconst, b1 = bconst;
                        if (btab) { int r0 = t - key; r0 = r0 < 0 ? 0 : (r0 > 127 ? 128 : r0); int r1 = t - key - 32; r1 = r1 < 0 ? 0 : (r1 > 127 ? 128 : r1);
                            b0 = r0 == 128 ? bconst : tab[head * 128 + r0]; b1 = r1 == 128 ? bconst : tab[head * 128 + r1]; }
                        const float x0 = fmaf(s0[r], xscale, b0), x1 = fmaf(s1[r], xscale, b1);
                        const int k0 = __builtin_amdgcn_sbfe(mlo, kk, 1), k1 = __builtin_amdgcn_sbfe(mhi, kk, 1);
                        s0[r] = __int_as_float((__float_as_int(x0) & k0) | (~k0 & (int)0xff800000)); s1[r] = __int_as_float((__float_as_int(x1) & k1) | (~k1 & (int)0xff800000));
                        mloc = fmaxf(mloc, fmaxf(s0[r], s1[r])); }
                }
                mloc = fmaxf(mloc, __shfl_xor(mloc, 32));
                const float mnew = fmaxf(mrun, mloc);
                if (__any(mnew > mrun)) {
                    const float alpha = __builtin_amdgcn_exp2f(mrun - mnew); mrun = mnew;
                    lsum *= alpha;
#pragma unroll
                    for (int i = 0; i < 4; ++i)
#pragma unroll
                        for (int r = 0; r < 16; ++r) o[i][r] *= alpha;
                }
                float ps = 0.f;
#pragma unroll
                for (int r = 0; r < 16; ++r) { s0[r] = __builtin_amdgcn_exp2f(s0[r] - mnew); s1[r] = __builtin_amdgcn_exp2f(s1[r] - mnew); ps += s0[r] + s1[r]; }
                lsum += ps;
            }
            bf16x8 pf[2][2];
#pragma unroll
            for (int s2 = 0; s2 < 2; ++s2) {
                pf[0][s2] = pack8(s0[8 * s2], s0[8 * s2 + 1], s0[8 * s2 + 2], s0[8 * s2 + 3], s0[8 * s2 + 4], s0[8 * s2 + 5], s0[8 * s2 + 6], s0[8 * s2 + 7]);
                pf[1][s2] = pack8(s1[8 * s2], s1[8 * s2 + 1], s1[8 * s2 + 2], s1[8 * s2 + 3], s1[8 * s2 + 4], s1[8 * s2 + 5], s1[8 * s2 + 6], s1[8 * s2 + 7]);
            }
            if (MODE != AT_DSA) {
            bf16x8 vb2[8];
            __builtin_amdgcn_sched_barrier(0);
#pragma unroll
            for (int dt = 2; dt < 4; ++dt)
#pragma unroll
                for (int ks = 0; ks < 4; ++ks) { const LAS unsigned char* vp = vp0 + 32 * dt * AT_VSTR + 32 * ks;
                    vb2[4 * (dt - 2) + ks] = __builtin_shufflevector(*(const LAS s16x4*)vp, *(const LAS s16x4*)(vp + 16), 0, 1, 2, 3, 4, 5, 6, 7); }
            __builtin_amdgcn_sched_barrier(0);
#pragma unroll
            for (int dt = 0; dt < 2; ++dt)
#pragma unroll
                for (int ks = 0; ks < 4; ++ks) o[dt] = MFMA32(va[4 * dt + ks], pf[ks >> 1][ks & 1], o[dt]);
            __builtin_amdgcn_sched_barrier(0);
#pragma unroll
            for (int dt = 2; dt < 4; ++dt)
#pragma unroll
                for (int ks = 0; ks < 4; ++ks) o[dt] = MFMA32(vb2[4 * (dt - 2) + ks], pf[ks >> 1][ks & 1], o[dt]);
            } else {
#pragma unroll
            for (int dt = 0; dt < 4; ++dt) {
                bf16x8 vd[4];
#pragma unroll
                for (int ks = 0; ks < 4; ++ks) { const LAS unsigned char* vp = vp0 + 32 * dt * AT_VSTR + 32 * ks;
                    vd[ks] = __builtin_shufflevector(*(const LAS s16x4*)vp, *(const LAS s16x4*)(vp + 16), 0, 1, 2, 3, 4, 5, 6, 7); }
                __builtin_amdgcn_sched_barrier(0);
#pragma unroll
                for (int ks = 0; ks < 4; ++ks) o[dt] = MFMA32(vd[ks], pf[ks >> 1][ks & 1], o[dt]);
                __builtin_amdgcn_sched_barrier(0);
            } }
        }
        if (j + 1 < nkt) commit((j + 1) & 1);
        __syncthreads();
    }
    if (MODE == AT_RET) {
        const int nc0 = q0 / 128;
        const bf16_t* RT = (const bf16_t*)(c.ws + WS_KVT) + (size_t)((b * 4 + head) * 32 + nc0) * 32768;
#pragma unroll
        for (int p = 0; p < 8; ++p) { const int idx = tid + 512 * p, hsel = idx >> 11, rem = idx & 2047, row = rem >> 4, ch = rem & 15;
            *(LAS u32x4*)(lds + hsel * AT_BUF + row * AT_KSTR + ch * 16) = *(const u32x4*)(RT + (size_t)hsel * 32768 + row * 128 + ch * 8); }
        const float xi = exp2f(lg * (float)(((qw0 + l31) & 127) + 1));
#pragma unroll
        for (int s = 0; s < 8; ++s) { const u32x4 wv = __builtin_bit_cast(u32x4, qf[s]);
            qf[s] = pack8(lo_bf(wv.x) * xi, hi_bf(wv.x) * xi, lo_bf(wv.y) * xi, hi_bf(wv.y) * xi, lo_bf(wv.z) * xi, hi_bf(wv.z) * xi, lo_bf(wv.w) * xi, hi_bf(wv.w) * xi); }
        __syncthreads();
        const LAS unsigned char* rp0 = lds + (w >> 2) * AT_BUF + l31 * AT_KSTR + 16 * hf;
#pragma unroll
        for (int dt = 0; dt < 4; ++dt) {
            bf16x8 ra[8];
#pragma unroll
            for (int s = 0; s < 8; ++s) ra[s] = *(const LAS bf16x8*)(rp0 + 32 * dt * AT_KSTR + 32 * s);
            __builtin_amdgcn_sched_barrier(0);
#pragma unroll
            for (int s = 0; s < 8; ++s) o[dt] = MFMA32(ra[s], qf[s], o[dt]);
            __builtin_amdgcn_sched_barrier(0);
        }
    }
    bf16_t* Op = WSP(bf16_t, WS_BR) + (size_t)(b * SEQ + t) * D + ocol;
    if (MODE == AT_RET) {
        float s = 0.f;
#pragma unroll
        for (int i = 0; i < 4; ++i)
#pragma unroll
            for (int r = 0; r < 16; ++r) s += o[i][r];
        s += __shfl_xor(s, 32);
        const float mu = s * (1.f / 128.f); float v = 0.f;
#pragma unroll
        for (int i = 0; i < 4; ++i)
#pragma unroll
            for (int r = 0; r < 16; ++r) { const float d = o[i][r] - mu; v += d * d; }
        v += __shfl_xor(v, 32);
        const float rs = rsqrtf(v * (1.f / 128.f) + EPS);
        const bf16_t* gp = P + (size_t)(b * SEQ + t) * NP + C_RG + head * 128;
#pragma unroll
        for (int i = 0; i < 4; ++i)
#pragma unroll
            for (int g = 0; g < 4; ++g) { const int d0 = 32 * i + 8 * g + 4 * hf;
                const u32x2 gw = *(const u32x2*)(gp + d0);
                u32x2 wv; wv.x = pk2((o[i][4 * g] - mu) * rs * siluf_(lo_bf(gw.x)), (o[i][4 * g + 1] - mu) * rs * siluf_(hi_bf(gw.x)));
                wv.y = pk2((o[i][4 * g + 2] - mu) * rs * siluf_(lo_bf(gw.y)), (o[i][4 * g + 3] - mu) * rs * siluf_(hi_bf(gw.y)));
                *(u32x2*)(Op + d0) = wv; }
    } else {
        const float lt = lsum + __shfl_xor(lsum, 32), inv = 1.f / lt;
#pragma unroll
        for (int i = 0; i < 4; ++i)
#pragma unroll
            for (int g = 0; g < 4; ++g) { const int d0 = 32 * i + 8 * g + 4 * hf;
                u32x2 wv; wv.x = pk2(o[i][4 * g] * inv, o[i][4 * g + 1] * inv); wv.y = pk2(o[i][4 * g + 2] * inv, o[i][4 * g + 3] * inv);
                *(u32x2*)(Op + d0) = wv; }
    }
}

constexpr int IX_QSTR = 2064;
DI void idx_unit(const Ctx& c, int b, int q0) {
    LAS unsigned char* lds = c.lds;
    const int tid = c.tid, w = c.wave, lane = c.lane, l31 = lane & 31, hf = lane >> 5;
    const bf16_t* QD = WSP(bf16_t, WS_QD); const bf16_t* P = WSP(bf16_t, WS_PROJ); float* SC = WSP(float, WS_SC);
    const int t = q0 + l31;
    __syncthreads();
#pragma unroll
    for (int p = 0; p < 8; ++p) { const int idx = tid + 512 * p, r = idx >> 7, ch = idx & 127;
        *(LAS u32x4*)(lds + r * IX_QSTR + ch * 16) = *(const u32x4*)(QD + (size_t)(b * SEQ + q0 + r) * 1536 + 512 + ch * 8); }
    LAS float* wtab = (LAS float*)(lds + 32 * IX_QSTR);
    { const int r = tid >> 4, hh = tid & 15; wtab[hh * 32 + r] = bf2f(P[(size_t)(b * SEQ + q0 + r) * NP + C_IW + hh]) * 0.03125f; }
    __syncthreads();
    const int nkt = (q0 + 32 + 63) / 64;
    bf16x8 kn[2][4];
    { const int j0 = w < nkt ? w : 0;
#pragma unroll
      for (int k2 = 0; k2 < 2; ++k2) { const bf16_t* kp = P + (size_t)(b * SEQ + 64 * j0 + 32 * k2 + l31) * NP + C_IK + 8 * hf;
#pragma unroll
          for (int s = 0; s < 4; ++s) kn[k2][s] = *(const bf16x8*)(kp + 16 * s); } }
    for (int jt = w; jt < nkt; jt += 8) {
        bf16x8 kf[2][4];
#pragma unroll
        for (int k2 = 0; k2 < 2; ++k2)
#pragma unroll
            for (int s = 0; s < 4; ++s) kf[k2][s] = kn[k2][s];
        { const int jn = jt + 8 < nkt ? jt + 8 : jt;
#pragma unroll
          for (int k2 = 0; k2 < 2; ++k2) { const bf16_t* kp = P + (size_t)(b * SEQ + 64 * jn + 32 * k2 + l31) * NP + C_IK + 8 * hf;
#pragma unroll
              for (int s = 0; s < 4; ++s) kn[k2][s] = *(const bf16x8*)(kp + 16 * s); } }
        f32x16 a0, a1;
#pragma unroll
        for (int r = 0; r < 16; ++r) { a0[r] = 0.f; a1[r] = 0.f; }
#pragma unroll 1
        for (int h = 0; h < 16; ++h) {
            f32x16 c0, c1;
#pragma unroll
            for (int r = 0; r < 16; ++r) { c0[r] = 0.f; c1[r] = 0.f; }
            const float wh = wtab[h * 32 + l31];
            const LAS unsigned char* qp = lds + l31 * IX_QSTR + h * 128 + 16 * hf;
#pragma unroll
            for (int s = 0; s < 4; ++s) { const bf16x8 bq = *(const LAS bf16x8*)(qp + 32 * s);
                c0 = MFMA32(kf[0][s], bq, c0); c1 = MFMA32(kf[1][s], bq, c1); }
#pragma unroll
            for (int r = 0; r < 16; ++r) { a0[r] += wh * fmaxf(c0[r], 0.f); a1[r] += wh * fmaxf(c1[r], 0.f); }
        }
        float* dst = SC + (size_t)(b * SEQ + t) * SC_LD + 64 * jt + 4 * hf;
#pragma unroll
        for (int g = 0; g < 4; ++g) { *(f32x4*)(dst + 8 * g) = (f32x4){a0[4 * g], a0[4 * g + 1], a0[4 * g + 2], a0[4 * g + 3]};
            *(f32x4*)(dst + 32 + 8 * g) = (f32x4){a1[4 * g], a1[4 * g + 1], a1[4 * g + 2], a1[4 * g + 3]}; }
    }
}
constexpr int SEL_WORDS = 2048 + 256 + 64;
DI int sel_bin(float v, float scale, float off) { return (int)__builtin_amdgcn_fmed3f(fmaf(v, scale, off), 0.f, 2047.f); }
DI void select_rows(const Ctx& c) {
    const int gw = c.bid * 8 + c.wave, NGW = c.G * 8;
    const float* SC = WSP(float, WS_SC); unsigned long long* MK = WSP(unsigned long long, WS_MASK);
    LAS unsigned* hist = (LAS unsigned*)(c.lds) + c.wave * SEL_WORDS;
    LAS float* list = (LAS float*)(hist + 2048);
    const float NINF = -__builtin_inff(), PINF = __builtin_inff();
    for (int m = gw; m < M; m += NGW) {
        int lane = c.lane; asm volatile("" : "+v"(lane));
        const int t = m & (SEQ - 1), jmax = t >> 6;
        const float* row = SC + (size_t)m * SC_LD;
        float val[64];
#pragma unroll
        for (int j = 0; j < 64; ++j) val[j] = NINF;
#pragma unroll
        for (int j8 = 0; j8 < 8; ++j8) {
            if (8 * j8 + 7 < jmax) {
#pragma unroll
                for (int j = 8 * j8; j < 8 * j8 + 8; ++j) val[j] = row[64 * j + lane]; }
            else if (8 * j8 <= jmax) {
#pragma unroll
                for (int j = 8 * j8; j < 8 * j8 + 8; ++j) { const int s = 64 * j + lane; const float v = row[s <= t ? s : t]; val[j] = s <= t ? v : NINF; } } }
        float thr = NINF;
        if (t >= 256) {
            float lo = PINF, hi = NINF;
#pragma unroll
            for (int j8 = 0; j8 < 8; ++j8) {
                if (8 * j8 + 7 < jmax) {
#pragma unroll
                    for (int j = 8 * j8; j < 8 * j8 + 8; ++j) { hi = fmaxf(hi, val[j]); lo = fminf(lo, val[j]); } }
                else if (8 * j8 <= jmax) {
#pragma unroll
                    for (int j = 8 * j8; j < 8 * j8 + 8; ++j) { hi = fmaxf(hi, val[j]); lo = fminf(lo, val[j] == NINF ? PINF : val[j]); } } }
#pragma unroll
            for (int o = 1; o < 64; o <<= 1) { hi = fmaxf(hi, __shfl_xor(hi, o)); lo = fminf(lo, __shfl_xor(lo, o)); }
            const float scale = (hi > lo) ? 2046.f / (hi - lo) : 0.f, off = 1.f - lo * scale;
            asm volatile("s_waitcnt lgkmcnt(0)" ::: "memory");
#pragma unroll
            for (int q = 0; q < 8; ++q) *(LAS u32x4*)(hist + 32 * lane + 4 * q) = (u32x4){0u, 0u, 0u, 0u};
            asm volatile("s_waitcnt lgkmcnt(0)" ::: "memory");
#pragma unroll
            for (int j8 = 0; j8 < 8; ++j8) if (8 * j8 <= jmax) {
#pragma unroll
                for (int j = 8 * j8; j < 8 * j8 + 8; ++j) __hip_atomic_fetch_add(hist + sel_bin(val[j], scale, off), 1u, __ATOMIC_RELAXED, __HIP_MEMORY_SCOPE_WORKGROUP); }
            asm volatile("s_waitcnt lgkmcnt(0)" ::: "memory");
            int T = 0;
#pragma unroll
            for (int q = 0; q < 8; ++q) { const u32x4 v = *(const LAS u32x4*)(hist + 32 * lane + 4 * q); T += (int)(v.x + v.y + v.z + v.w); }
            if (lane == 0) T -= (int)hist[0];
            int S = T;
#pragma unroll
            for (int o = 1; o < 64; o <<= 1) { const int v = __shfl_down(S, o); if (lane + o < 64) S += v; }
            const unsigned long long bm = __ballot(S >= 256);
            const int L = 63 - __builtin_clzll(bm | 1ull);
            const int need2 = 256 - (S - T);
            int run = 0, bsel = 0, above = 0, inb = 0; bool found = false;
#pragma unroll
            for (int q = 7; q >= 0; --q) { const u32x4 v = *(const LAS u32x4*)(hist + 32 * lane + 4 * q);
#pragma unroll
                for (int e = 3; e >= 0; --e) { const int h = (int)v[e]; run += h; if (!found && run >= need2) { found = true; bsel = 4 * q + e; above = run - h; inb = h; } } }
            const int B0 = 32 * L + __builtin_amdgcn_readlane(bsel, L);
            const int need = __builtin_amdgcn_readlane(need2, L) - __builtin_amdgcn_readlane(above, L);
            const int cnt = __builtin_amdgcn_readlane(inb, L);
            if (cnt <= 256 && B0 > 0) {
                int pos = 0;
#pragma unroll
                for (int j8 = 0; j8 < 8; ++j8) if (8 * j8 <= jmax) {
#pragma unroll
                  for (int j = 8 * j8; j < 8 * j8 + 8; ++j) { const float v = val[j];
                    const bool in = sel_bin(v, scale, off) == B0;
                    const unsigned long long mm = __ballot(in);
                    if (mm != 0ull) { const int p = pos + (int)__builtin_amdgcn_mbcnt_hi((unsigned)(mm >> 32), __builtin_amdgcn_mbcnt_lo((unsigned)mm, 0u)); if (in) list[p] = v; pos += __builtin_popcountll(mm); }
                    if ((j & 3) == 3) __builtin_amdgcn_sched_barrier(0); } }
                asm volatile("s_waitcnt lgkmcnt(0)" ::: "memory");
                float best = NINF;
                for (int i0 = 0; i0 < cnt; i0 += 64) { const int i = i0 + lane; const float mine = i < cnt ? list[i] : PINF; int rk = 0;
                    for (int k = 0; k < cnt; ++k) rk += (list[k] >= mine) ? 1 : 0;
                    if (i < cnt && rk >= need) best = fmaxf(best, mine); }
#pragma unroll
                for (int o = 1; o < 64; o <<= 1) best = fmaxf(best, __shfl_xor(best, o));
                thr = best;
            } else {
                unsigned prefix = 0u;
                for (int bit = 31; bit >= 0; --bit) { const unsigned cand = prefix | (1u << bit); int cn = 0;
#pragma unroll
                    for (int j = 0; j < 64; ++j) { const unsigned u = __float_as_uint(val[j]); const unsigned k = val[j] == NINF ? 0u : ((u & 0x80000000u) ? ~u : (u | 0x80000000u)); cn += (k >= cand) ? 1 : 0; }
#pragma unroll
                    for (int o = 1; o < 64; o <<= 1) cn += __shfl_xor(cn, o);
                    if (cn >= 256) prefix = cand; }
                thr = __uint_as_float((prefix & 0x80000000u) ? (prefix & 0x7fffffffu) : ~prefix);
            }
        }
        int mlo = 0, mhi = 0;
#pragma unroll
        for (int j8 = 0; j8 < 8; ++j8) if (8 * j8 <= jmax) {
#pragma unroll
          for (int j = 8 * j8; j < 8 * j8 + 8; ++j) { const unsigned long long bm = __ballot(val[j] >= thr);
            asm volatile("s_nop 4\n\tv_writelane_b32 %0, %2, %4\n\tv_writelane_b32 %1, %3, %4" : "+v"(mlo), "+v"(mhi) : "s"((unsigned)bm), "s"((unsigned)(bm >> 32)), "n"(j)); } }
        unsigned long long mine = ((unsigned long long)(unsigned)mhi << 32) | (unsigned)mlo;
        if (t < 256) mine = (64 * lane + 63 <= t) ? ~0ull : (64 * lane > t ? 0ull : ((2ull << (t - 64 * lane)) - 1ull));
        MK[(size_t)m * 64 + lane] = mine;
    }
}
constexpr int GP_KN = 0;
constexpr int GP_VV = 33024;
constexpr int GP_KB = 65792;
constexpr int GP_QB = 83200;
constexpr int GP_L = 100608;
constexpr int GP_BETA = 118016, GP_G = 118272, GP_EG = 118528;
DI void gdn_prep(const Ctx& c, int l, int unit) {
    LAS unsigned char* lds = c.lds;
    const int tid = c.tid, w = c.wave, lane = c.lane, l31 = lane & 31, hf = lane >> 5;
    const int n = unit & 63, h = (unit >> 6) & 3, b = unit >> 8;
    const int row0 = b * SEQ + n * 64;
    const bf16_t* P = WSP(bf16_t, WS_PROJ);
    LAS float* kn = (LAS float*)(lds + GP_KN); LAS float* vv = (LAS float*)(lds + GP_VV);
    LAS bf16_t* kb = (LAS bf16_t*)(lds + GP_KB); LAS bf16_t* qb = (LAS bf16_t*)(lds + GP_QB);
    LAS float* Lm = (LAS float*)(lds + GP_L); LAS float* beta = (LAS float*)(lds + GP_BETA); LAS float* gg = (LAS float*)(lds + GP_G); LAS float* eg = (LAS float*)(lds + GP_EG);
    __syncthreads();
    if (w == 0) {
        const float bl = bf2f(P[(size_t)(row0 + lane) * NP + C_GB + h]), al = bf2f(P[(size_t)(row0 + lane) * NP + C_GA + h]);
        const float A = __expf(INP(IN_GDN_ALOG)[l * 4 + h]); const float xx = al + INP(IN_GDN_DT)[l * 4 + h];
        const float sp = xx > 20.f ? xx : __logf(1.f + __expf(xx));
        float g = -A * sp;
#pragma unroll
        for (int o = 1; o < 64; o <<= 1) { const float tt = __shfl_up(g, o); if (lane >= o) g += tt; }
        beta[lane] = sigmoidf_(bl); gg[lane] = g; eg[lane] = __expf(g);
    }
    {
        const int tok = tid >> 3, part = tid & 7, pos = n * 64 + tok;
        const float* cwl = INP(IN_GDN_CONV) + (size_t)l * 4 * 1536;
#pragma unroll
        for (int which = 0; which < 3; ++which) {
            const int ccol = which * 512 + h * 128 + 16 * part;
            float y[16];
#pragma unroll
            for (int e = 0; e < 16; ++e) y[e] = 0.f;
#pragma unroll
            for (int i = 0; i < 4; ++i) {
                {
                    const int dlt = (pos - 3 + i >= 0) ? (i - 3) : 0;
                    const float live = (pos - 3 + i >= 0) ? 1.f : 0.f;
                    const bf16_t* src = P + (size_t)(row0 + tok + dlt) * NP + C_GQ + ccol;
                    const u32x4 x0 = *(const u32x4*)src, x1 = *(const u32x4*)(src + 8);
                    const float* wp = cwl + i * 1536 + ccol;
                    const f32x4 w0 = *(const f32x4*)wp * live, w1 = *(const f32x4*)(wp + 4) * live, w2 = *(const f32x4*)(wp + 8) * live, w3 = *(const f32x4*)(wp + 12) * live;
                    y[0] += w0.x * lo_bf(x0.x); y[1] += w0.y * hi_bf(x0.x); y[2] += w0.z * lo_bf(x0.y); y[3] += w0.w * hi_bf(x0.y);
                    y[4] += w1.x * lo_bf(x0.z); y[5] += w1.y * hi_bf(x0.z); y[6] += w1.z * lo_bf(x0.w); y[7] += w1.w * hi_bf(x0.w);
                    y[8] += w2.x * lo_bf(x1.x); y[9] += w2.y * hi_bf(x1.x); y[10] += w2.z * lo_bf(x1.y); y[11] += w2.w * hi_bf(x1.y);
                    y[12] += w3.x * lo_bf(x1.z); y[13] += w3.y * hi_bf(x1.z); y[14] += w3.z * lo_bf(x1.w); y[15] += w3.w * hi_bf(x1.w);
                }
            }
            float ss = 0.f;
#pragma unroll
            for (int e = 0; e < 16; ++e) { y[e] = siluf_(y[e]); ss += y[e] * y[e]; }
            if (which < 2) {
                ss += __shfl_xor(ss, 1); ss += __shfl_xor(ss, 2); ss += __shfl_xor(ss, 4);
                const float r = rsqrtf(ss + EPS) * (which == 0 ? SM_SCALE : 1.f);
#pragma unroll
                for (int e = 0; e < 16; ++e) y[e] *= r;
                LAS bf16_t* dstb = (which == 0 ? qb : kb) + tok * 136 + 16 * part;
#pragma unroll
                for (int e = 0; e < 16; e += 2) *(LAS unsigned*)(dstb + e) = pk2(y[e], y[e + 1]);
                if (which == 1) {
#pragma unroll
                    for (int e = 0; e < 16; ++e) kn[tok * 129 + 16 * part + e] = y[e]; }
            } else {
#pragma unroll
                for (int e = 0; e < 16; ++e) vv[tok * 128 + 16 * part + e] = y[e];
            }
        }
    }
    __syncthreads();
    {
        const int which = w >> 2, ti = (w >> 1) & 1, tj = w & 1;
        const LAS bf16_t* Ab = (which ? qb : kb) + (32 * ti + l31) * 136 + 8 * hf;
        const LAS bf16_t* Bb = kb + (32 * tj + l31) * 136 + 8 * hf;
        f32x16 acc;
#pragma unroll
        for (int r = 0; r < 16; ++r) acc[r] = 0.f;
#pragma unroll
        for (int s = 0; s < 8; ++s) acc = MFMA32(*(const LAS bf16x8*)(Ab + 16 * s), *(const LAS bf16x8*)(Bb + 16 * s), acc);
        const int sc = 32 * tj + l31; const float gs = gg[sc];
        bf16_t* QKM = WSP(bf16_t, WS_QKM) + (size_t)unit * 4096;
#pragma unroll
        for (int r = 0; r < 16; ++r) { const int cc = 32 * ti + crow(r, hf);
            const float dec = __expf(fminf(gg[cc] - gs, 0.f));
            if (which == 0) Lm[sc * 68 + cc] = (cc > sc) ? beta[cc] * acc[r] * dec : 0.f;
            else QKM[cc * 64 + sc] = f2bf((cc >= sc) ? acc[r] * dec : 0.f); }
    }
    __syncthreads();
    if (tid < 256) {
        float x[64];
        if (tid < 128) {
#pragma unroll
            for (int i = 0; i < 64; ++i) x[i] = vv[i * 128 + tid] * beta[i]; }
        else {
#pragma unroll
            for (int i = 0; i < 64; ++i) x[i] = kn[i * 129 + tid - 128] * (beta[i] * eg[i]); }
        int zv = 0; asm volatile("" : "+v"(zv));
        const LAS float* Lz = Lm + zv;
        f32x4 colv[2][16];
#pragma unroll
        for (int g = 0; g < 16; ++g) colv[0][g] = *(const LAS f32x4*)(Lz + 4 * g);
#pragma unroll
        for (int j = 0; j < 63; ++j) { const float xj = x[j];
            if (j + 1 < 63) {
#pragma unroll
                for (int g = (j + 2) >> 2; g < 16; ++g) colv[(j + 1) & 1][g] = *(const LAS f32x4*)(Lz + (j + 1) * 68 + 4 * g); }
            __builtin_amdgcn_sched_barrier(0);
#pragma unroll
            for (int g = (j + 1) >> 2; g < 16; ++g) { const f32x4 lv = colv[j & 1][g];
                x[4 * g] -= lv.x * xj; x[4 * g + 1] -= lv.y * xj; x[4 * g + 2] -= lv.z * xj; x[4 * g + 3] -= lv.w * xj; }
            __builtin_amdgcn_sched_barrier(0); }
        if (tid < 128) { float* U0 = WSP(float, WS_U0) + (size_t)row0 * 512 + h * 128 + tid;
#pragma unroll
            for (int i = 0; i < 64; ++i) U0[(size_t)i * 512] = x[i]; }
        else { bf16_t* KC = WSP(bf16_t, WS_KCUM) + (size_t)row0 * 512 + h * 128 + tid - 128;
#pragma unroll
            for (int i = 0; i < 64; ++i) KC[(size_t)i * 512] = f2bf(x[i]); }
    } else {
        const int t2 = tid - 256; const float gl = gg[63];
        bf16_t* QDEC = WSP(bf16_t, WS_QDEC) + (size_t)row0 * 512 + h * 128;
#pragma unroll 4
        for (int k = 0; k < 32; ++k) { const int e = t2 + 256 * k, cc = e >> 7, d = e & 127; QDEC[(size_t)cc * 512 + d] = f2bf(bf2f(qb[cc * 136 + d]) * eg[cc]); }
        bf16_t* KDT = WSP(bf16_t, WS_KDT) + (size_t)unit * 8192;
#pragma unroll 4
        for (int k = 0; k < 32; ++k) { const int e = t2 + 256 * k, d = e >> 6, cc = e & 63; KDT[d * 64 + cc] = f2bf(kn[cc * 129 + d] * __expf(gl - gg[cc])); }
        if (t2 == 0) WSP(float, WS_EGL)[unit] = __expf(gl);
    }
}

constexpr int GS_KC = 0, GS_QD = 16896, GS_QK = 33792, GS_KD = 42496, GS_BUF = 59904;
DI void gdn_scan(const Ctx& c, int item) {
    LAS unsigned char* lds = c.lds;
    const int tid = c.tid, w = c.wave, lane = c.lane, l31 = lane & 31, hf = lane >> 5;
    const int b = item >> 2, h = item & 3;
    const bf16_t* KC = WSP(bf16_t, WS_KCUM) + (size_t)(b * SEQ) * 512 + h * 128;
    const bf16_t* QDc = WSP(bf16_t, WS_QDEC) + (size_t)(b * SEQ) * 512 + h * 128;
    const bf16_t* QKM = WSP(bf16_t, WS_QKM) + (size_t)(b * 4 + h) * 64 * 4096;
    const bf16_t* KDT = WSP(bf16_t, WS_KDT) + (size_t)(b * 4 + h) * 64 * 8192;
    const float* U0 = WSP(float, WS_U0) + (size_t)(b * SEQ) * 512 + h * 128;
    const float* EGL = WSP(float, WS_EGL) + (b * 4 + h) * 64;
    float* OG = WSP(float, WS_OG) + (size_t)(b * SEQ) * 512 + h * 128;
    u32x4 stA[14], stB[14];
#define GS_ISSUE(n_, st) do { const int t2 = tid - 256; \
        _Pragma("unroll") for (int k = 0; k < 4; ++k) { const int idx = t2 + 256 * k, cc = idx >> 4, ch = idx & 15; \
            st[k] = *(const u32x4*)(KC + (size_t)((n_) * 64 + cc) * 512 + ch * 8); st[4 + k] = *(const u32x4*)(QDc + (size_t)((n_) * 64 + cc) * 512 + ch * 8); } \
        _Pragma("unroll") for (int k = 0; k < 2; ++k) { const int idx = t2 + 256 * k; st[8 + k] = *(const u32x4*)(QKM + (size_t)(n_) * 4096 + idx * 8); } \
        _Pragma("unroll") for (int k = 0; k < 4; ++k) { const int idx = t2 + 256 * k; st[10 + k] = *(const u32x4*)(KDT + (size_t)(n_) * 8192 + idx * 8); } } while (0)
#define GS_COMMIT(buf_, st) do { const int t2 = tid - 256; LAS unsigned char* bb = lds + (buf_) * GS_BUF; \
        _Pragma("unroll") for (int k = 0; k < 4; ++k) { const int idx = t2 + 256 * k, cc = idx >> 4, ch = idx & 15; \
            LAS u32x2* d0 = (LAS u32x2*)(bb + GS_KC + cc * 264 + ch * 16); d0[0] = (u32x2){st[k].x, st[k].y}; d0[1] = (u32x2){st[k].z, st[k].w}; \
            LAS u32x2* d1 = (LAS u32x2*)(bb + GS_QD + cc * 264 + ch * 16); d1[0] = (u32x2){st[4 + k].x, st[4 + k].y}; d1[1] = (u32x2){st[4 + k].z, st[4 + k].w}; } \
        _Pragma("unroll") for (int k = 0; k < 2; ++k) { const int idx = t2 + 256 * k, cc = idx >> 3, ch = idx & 7; \
            LAS u32x2* d0 = (LAS u32x2*)(bb + GS_QK + cc * 136 + ch * 16); d0[0] = (u32x2){st[8 + k].x, st[8 + k].y}; d0[1] = (u32x2){st[8 + k].z, st[8 + k].w}; } \
        _Pragma("unroll") for (int k = 0; k < 4; ++k) { const int idx = t2 + 256 * k, dd = idx >> 3, ch = idx & 7; \
            LAS u32x2* d0 = (LAS u32x2*)(bb + GS_KD + dd * 136 + ch * 16); d0[0] = (u32x2){st[10 + k].x, st[10 + k].y}; d0[1] = (u32x2){st[10 + k].z, st[10 + k].w}; } } while (0)
    __syncthreads();
    if (w >= 4) { GS_ISSUE(0, stA); GS_COMMIT(0, stA); }
    __syncthreads();
    if (w >= 4) {
        GS_ISSUE(1, stA);
        for (int n = 0; n < 64; n += 2) {
            if (n + 2 < 64) GS_ISSUE(n + 2, stB);
            if (n + 1 < 64) GS_COMMIT((n + 1) & 1, stA);
            __syncthreads();
            if (n + 3 < 64) GS_ISSUE(n + 3, stA);
            if (n + 2 < 64) GS_COMMIT(n & 1, stB);
            __syncthreads();
        }
    } else {
    f32x16 S[4];
#pragma unroll
    for (int i = 0; i < 4; ++i)
#pragma unroll
        for (int r = 0; r < 16; ++r) S[i][r] = 0.f;
    f32x16 u[2]; float egl_n = 0.f;
    if (w < 4) { const int e0 = 32 * w + l31;
#pragma unroll
        for (int ct = 0; ct < 2; ++ct)
#pragma unroll
            for (int r = 0; r < 16; ++r) u[ct][r] = U0[(size_t)(32 * ct + crow(r, hf)) * 512 + e0];
        egl_n = EGL[0]; }
    for (int n = 0; n < 64; ++n) {
        {
            const LAS unsigned char* bb = lds + (n & 1) * GS_BUF;
            const int e0 = 32 * w + l31;
            const float egl = egl_n;
            bf16x8 Sb[8];
#pragma unroll
            for (int dt = 0; dt < 4; ++dt)
#pragma unroll
                for (int s2 = 0; s2 < 2; ++s2) Sb[2 * dt + s2] = pack8(S[dt][8 * s2], S[dt][8 * s2 + 1], S[dt][8 * s2 + 2], S[dt][8 * s2 + 3], S[dt][8 * s2 + 4], S[dt][8 * s2 + 5], S[dt][8 * s2 + 6], S[dt][8 * s2 + 7]);
#define GS_FRAG(p) __builtin_shufflevector(*(const LAS s16x4*)(p), *(const LAS s16x4*)((p) + 16), 0, 1, 2, 3, 4, 5, 6, 7)
            f32x16 a1[2];
#pragma unroll
            for (int ct = 0; ct < 2; ++ct) {
#pragma unroll
                for (int r = 0; r < 16; ++r) a1[ct][r] = 0.f;
                bf16x8 fr[8];
#pragma unroll
                for (int ks = 0; ks < 8; ++ks) fr[ks] = GS_FRAG(bb + GS_KC + (32 * ct + l31) * 264 + (16 * ks + 4 * hf) * 2);
                __builtin_amdgcn_sched_barrier(0);
#pragma unroll
                for (int ks = 0; ks < 8; ++ks) a1[ct] = MFMA32(fr[ks], Sb[ks], a1[ct]);
                __builtin_amdgcn_sched_barrier(0);
            }
            bf16x8 vb[4];
#pragma unroll
            for (int ct = 0; ct < 2; ++ct) {
#pragma unroll
                for (int r = 0; r < 16; ++r) u[ct][r] -= a1[ct][r];
#pragma unroll
                for (int s2 = 0; s2 < 2; ++s2) vb[2 * ct + s2] = pack8(u[ct][8 * s2], u[ct][8 * s2 + 1], u[ct][8 * s2 + 2], u[ct][8 * s2 + 3], u[ct][8 * s2 + 4], u[ct][8 * s2 + 5], u[ct][8 * s2 + 6], u[ct][8 * s2 + 7]);
            }
            f32x16 oo[2];
#pragma unroll
            for (int ct = 0; ct < 2; ++ct) {
#pragma unroll
                for (int r = 0; r < 16; ++r) oo[ct][r] = 0.f;
                bf16x8 fr[8];
#pragma unroll
                for (int ks = 0; ks < 8; ++ks) fr[ks] = GS_FRAG(bb + GS_QD + (32 * ct + l31) * 264 + (16 * ks + 4 * hf) * 2);
                __builtin_amdgcn_sched_barrier(0);
#pragma unroll
                for (int ks = 0; ks < 8; ++ks) oo[ct] = MFMA32(fr[ks], Sb[ks], oo[ct]);
                __builtin_amdgcn_sched_barrier(0);
            }
            { bf16x8 fr[8];
#pragma unroll
              for (int ct = 0; ct < 2; ++ct)
#pragma unroll
                  for (int ks = 0; ks < 4; ++ks) fr[4 * ct + ks] = GS_FRAG(bb + GS_QK + (32 * ct + l31) * 136 + (16 * ks + 4 * hf) * 2);
              __builtin_amdgcn_sched_barrier(0);
#pragma unroll
              for (int ct = 0; ct < 2; ++ct)
#pragma unroll
                  for (int ks = 0; ks < 4; ++ks) oo[ct] = MFMA32(fr[4 * ct + ks], vb[ks], oo[ct]);
              __builtin_amdgcn_sched_barrier(0); }
#pragma unroll
            for (int ct = 0; ct < 2; ++ct)
#pragma unroll
                for (int r = 0; r < 16; ++r) OG[(size_t)(n * 64 + 32 * ct + crow(r, hf)) * 512 + e0] = oo[ct][r];
            { const int nn = n + 1 < 64 ? n + 1 : n;
#pragma unroll
              for (int ct = 0; ct < 2; ++ct)
#pragma unroll
                  for (int r = 0; r < 16; ++r) u[ct][r] = U0[(size_t)(nn * 64 + 32 * ct + crow(r, hf)) * 512 + e0];
              egl_n = EGL[nn]; }
#pragma unroll
            for (int dh = 0; dh < 2; ++dh) {
                bf16x8 fr[8];
#pragma unroll
                for (int d2 = 0; d2 < 2; ++d2)
#pragma unroll
                    for (int ks = 0; ks < 4; ++ks) fr[4 * d2 + ks] = GS_FRAG(bb + GS_KD + (32 * (2 * dh + d2) + l31) * 136 + (16 * ks + 4 * hf) * 2);
#pragma unroll
                for (int d2 = 0; d2 < 2; ++d2)
#pragma unroll
                    for (int r = 0; r < 16; ++r) S[2 * dh + d2][r] *= egl;
                __builtin_amdgcn_sched_barrier(0);
#pragma unroll
                for (int d2 = 0; d2 < 2; ++d2)
#pragma unroll
                    for (int ks = 0; ks < 4; ++ks) S[2 * dh + d2] = MFMA32(fr[4 * d2 + ks], vb[ks], S[2 * dh + d2]);
                __builtin_amdgcn_sched_barrier(0);
            }
#undef GS_FRAG
        }
        __syncthreads();
    }
    }
}

DI void ret_chunk_kv(const Ctx& c, int unit) {
    LAS unsigned char* lds = c.lds;
    const int tid = c.tid, w = c.wave, lane = c.lane, l31 = lane & 31, hf = lane >> 5;
    const int n = unit & 31, h = (unit >> 5) & 3, b = unit >> 7;
    const int row0 = b * SEQ + 128 * n;
    const bf16_t* P = WSP(bf16_t, WS_PROJ);
    const float* cs = WSP(float, WS_ROPE); const float* sn = cs + SEQ * 64;
    LAS bf16_t* Vt = (LAS bf16_t*)lds; LAS bf16_t* Kt = (LAS bf16_t*)(lds + 128 * 272);
    const float lg = log2f(1.f - exp2f(-5.f - (float)h));
    __syncthreads();
#pragma unroll
    for (int p = 0; p < 4; ++p) { const int idx = tid + 512 * p, cc = idx >> 4, e8 = (idx & 15) * 8;
        const u32x4 vv = *(const u32x4*)(P + (size_t)(row0 + cc) * NP + C_RV + h * 128 + e8);
#pragma unroll
        for (int q = 0; q < 4; ++q) { Vt[(e8 + 2 * q) * 136 + cc] = (bf16_t)(vv[q] & 0xffffu); Vt[(e8 + 2 * q + 1) * 136 + cc] = (bf16_t)(vv[q] >> 16); } }
#pragma unroll
    for (int p = 0; p < 2; ++p) { const int idx = tid + 512 * p, cc = idx >> 3, i8 = (idx & 7) * 8;
        const bf16_t* kp = P + (size_t)(row0 + cc) * NP + C_RK + h * 128 + i8;
        const u32x4 k1 = *(const u32x4*)kp, k2 = *(const u32x4*)(kp + 64);
        const int pos = 128 * n + cc; const float zs = SM_SCALE * exp2f(lg * (float)(127 - cc));
        const f32x4 c0 = *(const f32x4*)(cs + pos * 64 + i8), c1 = *(const f32x4*)(cs + pos * 64 + i8 + 4), s0 = *(const f32x4*)(sn + pos * 64 + i8), s1 = *(const f32x4*)(sn + pos * 64 + i8 + 4);
#pragma unroll
        for (int q = 0; q < 4; ++q) {
            const float a0 = lo_bf(k1[q]), a1 = hi_bf(k1[q]), b0 = lo_bf(k2[q]), b1 = hi_bf(k2[q]);
            const float co0 = q < 2 ? c0[2 * q] : c1[2 * q - 4], co1 = q < 2 ? c0[2 * q + 1] : c1[2 * q - 3], si0 = q < 2 ? s0[2 * q] : s1[2 * q - 4], si1 = q < 2 ? s0[2 * q + 1] : s1[2 * q - 3];
            Kt[(i8 + 2 * q) * 136 + cc] = f2bf((a0 * co0 - b0 * si0) * zs); Kt[(i8 + 2 * q + 1) * 136 + cc] = f2bf((a1 * co1 - b1 * si1) * zs);
            Kt[(64 + i8 + 2 * q) * 136 + cc] = f2bf((a0 * si0 + b0 * co0) * zs); Kt[(64 + i8 + 2 * q + 1) * 136 + cc] = f2bf((a1 * si1 + b1 * co1) * zs); } }
    __syncthreads();
    float* KV = (float*)(c.ws + WS_KVT) + (size_t)unit * 16384;
    const int ei = w >> 1;
    bf16x8 af[8];
#pragma unroll
    for (int s = 0; s < 8; ++s) af[s] = *(const LAS bf16x8*)((LAS unsigned char*)Vt + (32 * ei + l31) * 272 + (16 * s + 8 * hf) * 2);
#pragma unroll
    for (int dd = 0; dd < 2; ++dd) { const int di = 2 * (w & 1) + dd;
        bf16x8 bf[8];
#pragma unroll
        for (int s = 0; s < 8; ++s) bf[s] = *(const LAS bf16x8*)((LAS unsigned char*)Kt + (32 * di + l31) * 272 + (16 * s + 8 * hf) * 2);
        f32x16 acc;
#pragma unroll
        for (int r = 0; r < 16; ++r) acc[r] = 0.f;
#pragma unroll
        for (int s = 0; s < 8; ++s) acc = MFMA32(af[s], bf[s], acc);
#pragma unroll
        for (int r = 0; r < 16; ++r) KV[(32 * ei + crow(r, hf)) * 128 + 32 * di + l31] = acc[r];
    }
}
DI void ret_scan(const Ctx& c, int item) {
    const int h = item & 3; const int tid = c.tid;
    float* base = (float*)(c.ws + WS_KVT) + (size_t)item * 32 * 16384;
    const float gc = exp2f(128.f * log2f(1.f - exp2f(-5.f - (float)h)));
    f32x4 st[8];
#pragma unroll
    for (int k = 0; k < 8; ++k) st[k] = (f32x4){0.f, 0.f, 0.f, 0.f};
    for (int n = 0; n < 32; ++n) {
        float* slot = base + (size_t)n * 16384;
        f32x4 kv[8];
#pragma unroll
        for (int k = 0; k < 8; ++k) kv[k] = *(const f32x4*)(slot + tid * 4 + 2048 * k);
        asm volatile("s_waitcnt vmcnt(0)" ::: "memory");
        __syncthreads();
#pragma unroll
        for (int k = 0; k < 8; ++k) { u32x2 wv; wv.x = pk2(st[k][0], st[k][1]); wv.y = pk2(st[k][2], st[k][3]); *(u32x2*)((bf16_t*)slot + tid * 4 + 2048 * k) = wv;
            st[k] = st[k] * gc + kv[k]; }
    }
}
constexpr int PH_PER_LAYER = 12, PH_FINAL = 1 + PH_PER_LAYER * DEPTH, N_PHASES = PH_FINAL + 1;
constexpr int LDS_INTAB = LDS_MISC + 64;
DI int qid_of(int l, int k) { return l * 16 + k; }
DI Ctx mkctx(unsigned char* ws, float* out, LAS unsigned char* lds) {
    Ctx c; c.lds = lds; c.misc = (volatile LAS unsigned*)(lds + LDS_MISC); c.ws = ws; c.ctl = (unsigned*)(ws + WS_CTL);
    c.tid = threadIdx.x; c.lane = c.tid & 63; c.wave = __builtin_amdgcn_readfirstlane(c.tid >> 6); c.G = gridDim.x; c.bid = blockIdx.x;
    c.inl = (const LAS unsigned long long*)(lds + LDS_INTAB); c.out = out; return c;
}
#define NOINL __device__ __forceinline__
#define FARGS unsigned char* ws, float* out, LAS unsigned char* lds
#define MK() Ctx c = mkctx(ws, out, lds); asm volatile("" : "+v"(c.tid)); c.lane = c.tid & 63; c.wave = __builtin_amdgcn_readfirstlane(c.tid >> 6); asm volatile("" : "+s"(c.G), "+s"(c.bid)); { unsigned char* w_ = c.ws; asm volatile("" : "+s"(w_)); c.ws = w_; c.ctl = (unsigned*)(w_ + WS_CTL); }
NOINL void f_prologue(FARGS) { MK(); make_tables(c); cvt_mixer0(c); x0_rows(c, INP(IN_X), WSP(bf16_t, WS_H), WSP(float, WS_RSP1), WSP(unsigned char, WS_XB8)); }
NOINL void f_cvt_early(FARGS, int l, int blk) { MK(); cvt_early_block(c, l, blk); }
NOINL void f_final(FARGS) { MK(); final_norm_bf(c, WSP(bf16_t, WS_H), c.out, INP(IN_FINAL_NORM)); }
NOINL void f_gemm_in(FARGS, int l) { MK();
    { int lp = -1; pg8::Sched S8, S16; S8.init(M, 8192, c.G, c.bid, 1); S16.init(M, C_GATE, c.G, c.bid, 1);
      row_factors_units(c, WSP(float, WS_RSP1), WSP(float, WS_RF), S8, lp); row_factors_units(c, WSP(float, WS_RSP1), WSP(float, WS_RF), S16, lp); }
    { pg8::Gemm g{(const bf16_t*)WSP(unsigned char, WS_XB8), (const bf16_t*)WSP(unsigned char, WS_WG8), D / 2, D / 2, 0, 0}; pg8::Sched S; S.init(M, 8192, c.G, c.bid, 1);
      pg8::EpiGate8 E{(unsigned char*)(WSP(bf16_t, WS_PROJ) + C_GATE), (size_t)NP * 2, WSP(float, WS_RF), 0.0078125f}; pg8::gemm_phase<pg8::EpiGate8, true, true>(c.lds, g, S, E, c.tid); }
    asm volatile("" : "+v"(c.tid)); c.lane = c.tid & 63;
    { pg8::Gemm g{WSP(bf16_t, WS_H), WSP(bf16_t, WS_WIN), D, D, 0, 0}; pg8::Sched S; S.init(M, C_GATE, c.G, c.bid, 1);
      pg8::EpiBf16 E{WSP(bf16_t, WS_PROJ), NP, WSP(float, WS_RF), 1 << 30, 1.f}; pg8::gemm_phase<pg8::EpiBf16>(c.lds, g, S, E, c.tid); }
    if (l >= 1 && c.bid >= 64) { LAS float* scr = nullptr; const int gw = (c.bid - 64) * 8 + c.wave, NGW = (c.G - 64) * 8;
        for (int it = gw; it < CI_LATE; it += NGW) cvt_late_item(c, l, it, scr); } }
NOINL void f_gemm_dsaq(FARGS) { MK(); pg8::Gemm g{WSP(bf16_t, WS_PROJ) + C_DCQ, WSP(bf16_t, WS_WDSA), NP, 384, 0, 0}; pg8::Sched S; S.init(M, 1536, c.G, c.bid, 1); pg8::EpiBf16 E{WSP(bf16_t, WS_QD), 1536, nullptr, 1 << 30, 1.f}; pg8::gemm_phase<pg8::EpiBf16>(c.lds, g, S, E, c.tid); }
NOINL void f_gemm_merge(FARGS) { MK(); pg8::Gemm g{WSP(bf16_t, WS_BR), WSP(bf16_t, WS_WBR), D, 512, 512 * 2, (size_t)D * 512 * 2}; pg8::Sched S; S.init(M, D, c.G, c.bid, 4); pg8::EpiMerge E{WSP(bf16_t, WS_RQ), WSP(bf16_t, WS_PROJ)};
    pg8::gemm_phase<pg8::EpiMerge>(c.lds, g, S, E, c.tid); }
NOINL void f_gemm_out(FARGS) { MK(); pg8::Gemm g{WSP(bf16_t, WS_RQ), WSP(bf16_t, WS_WOUT), D, D, 0, 0}; pg8::Sched S; S.init(M, D, c.G, c.bid, 1); pg8::EpiResid E{WSP(bf16_t, WS_H), D, WSP(float, WS_RSP2), nullptr}; pg8::gemm_phase<pg8::EpiResid>(c.lds, g, S, E, c.tid); }
NOINL void f_gemm_gate(FARGS, int l) { MK(); pg8::Gemm g{WSP(bf16_t, WS_H), WSP(bf16_t, WS_WG), D, D, 0, 0}; pg8::Sched S; S.init(M, FF, c.G, c.bid, 1);
    { int lp = -1; row_factors_units(c, WSP(float, WS_RSP2), WSP(float, WS_RF), S, lp); }
    pg8::EpiGateRel E{pg8::EpiBf16T<true>{WSP(bf16_t, WS_G), FF, WSP(float, WS_RF), 1 << 30, 1.f}, (pg8::gu32*)(c.ctl + CW_GF)}; pg8::gemm_phase<pg8::EpiGateRel>(c.lds, g, S, E, c.tid); }
NOINL void f_gemm_up(FARGS, int l) { MK(); pg8::Gemm g{WSP(bf16_t, WS_H), WSP(bf16_t, WS_WU), D, D, 0, 0};
    const int rot = (c.bid + (c.G / 16) * 8) % c.G;
    pg8::Sched S; S.init(M, FF, c.G, rot, 1);
    { int lp = -1; row_factors_units(c, WSP(float, WS_RSP2), WSP(float, WS_RF), S, lp); }
    pg8::EpiUpAcq E{pg8::EpiUp{WSP(bf16_t, WS_ACT), WSP(bf16_t, WS_G), INP(IN_FFN_CONV) + (size_t)l * 3 * FF, INP(IN_FFN_CONVB) + (size_t)l * FF, WSP(float, WS_RF)}, (pg8::gu32*)(c.ctl + CW_GF), 8u * (unsigned)(l + 1)};
    pg8::gemm_phase<pg8::EpiUpAcq>(c.lds, g, S, E, c.tid); }
NOINL void f_gemm_down(FARGS) { MK(); pg8::Gemm g{WSP(bf16_t, WS_ACT), WSP(bf16_t, WS_WD), FF, FF, 0, 0}; pg8::Sched S; S.init(M, D, c.G, c.bid, 1); pg8::EpiResid E{WSP(bf16_t, WS_H), D, WSP(float, WS_RSP1), WSP(unsigned char, WS_XB8)}; pg8::gemm_phase<pg8::EpiResid>(c.lds, g, S, E, c.tid); }
NOINL void f_gdn_prep(FARGS, int l, int it) { MK(); gdn_prep(c, l, it); }
NOINL void f_prep_tok(FARGS, int it) { MK(); prep_tokens(c, it); }
NOINL void f_cfox(FARGS, int l, int it) { MK(); prep_cfox(c, it, l); }
NOINL void f_gdn_scan(FARGS, int it) { MK(); gdn_scan(c, it); }
NOINL void f_idx(FARGS, int b, int q0) { MK(); idx_unit(c, b, q0); }
NOINL void f_attn_fox(FARGS, int l, int b, int h, int q0) { MK(); attn_unit<AT_FOX>(c, l, b, h, q0); }
NOINL void f_attn_ret(FARGS, int l, int b, int h, int q0) { MK(); attn_unit<AT_RET>(c, l, b, h, q0); }
NOINL void f_ret_kv(FARGS, int unit) { MK(); ret_chunk_kv(c, unit); }
NOINL void f_ret_scan(FARGS, int item) { MK(); ret_scan(c, item); }
NOINL void f_attn_dsa(FARGS, int l, int b, int q0) { MK(); attn_unit<AT_DSA>(c, l, b, 0, q0); }
NOINL void f_select(FARGS) { MK(); select_rows(c); }
NOINL void f_gdn_fin(FARGS, int l) { MK(); gdn_finish(c, l); }

__global__ void __launch_bounds__(512, 2) fwd_kernel(Params prm) {
    extern __shared__ __attribute__((aligned(16))) unsigned char lds_raw[];
    LAS unsigned char* lds = (LAS unsigned char*)lds_raw; unsigned char* ws = prm.ws; float* out = prm.out;
    Ctx c = mkctx(ws, out, lds);
    if (c.tid < 16) c.misc[c.tid] = 0u;
    if (c.tid < 21) ((LAS unsigned long long*)(lds + LDS_INTAB))[c.tid] = (unsigned long long)prm.in[c.tid];
    __syncthreads();
    const int lo = prm.ph_lo, hi = prm.ph_hi;
    XcdBarrier bar = xcd_barrier_post(c.ctl + CW_BAR, c.misc + 8);
#define A ws, out, lds
#define LAUNDER() do { asm volatile("" : "+s"(ws), "+s"(out)); unsigned la_ = (unsigned)(size_t)lds; asm volatile("" : "+s"(la_)); lds = (LAS unsigned char*)(size_t)la_; c = mkctx(ws, out, lds); asm volatile("" : "+v"(c.tid)); c.lane = c.tid & 63; } while (0)
#define IN_PH(k) (lo <= (k) && (k) < hi)
#define SEAM(k) do { if (IN_PH(k) && IN_PH((k) + 1)) xcd_barrier(bar); LAUNDER(); } while (0)
    if (IN_PH(0)) f_prologue(A);
    SEAM(0);
    for (int l = 0; l < DEPTH; ++l) {
        const int pb = 1 + PH_PER_LAYER * l;
        if (IN_PH(pb + 1)) f_gemm_in(A, l);
        SEAM(pb + 1);
        if (IN_PH(pb + 2)) {
            for (;;) { const int it = q_next(c, qid_of(l, 0)); if (it >= 1024) break; f_gdn_prep(A, l, it); }
            LAUNDER();
            for (;;) { const int it = q_next(c, qid_of(l, 9)); if (it >= 512) break; f_ret_kv(A, it); }
            LAUNDER();
            for (;;) { const int it = q_next(c, qid_of(l, 1)); if (it >= 256) break; f_prep_tok(A, it); }
            LAUNDER();
            for (;;) { const int it = q_next(c, qid_of(l, 2)); if (it >= 16) break; f_cfox(A, l, it); }
            LAUNDER();
            __syncthreads();
            f_gemm_dsaq(A);
        }
        SEAM(pb + 2);
        if (IN_PH(pb + 3)) {
            for (;;) { const int it = q_next(c, qid_of(l, 3)); if (it >= 16) break; f_gdn_scan(A, it); }
            LAUNDER();
            for (;;) { const int i = q_next(c, qid_of(l, 4)); if (i >= 512) break; f_idx(A, i & 3, 32 * (127 - (i >> 2))); }
            LAUNDER();
            for (;;) { const int i = q_next(c, qid_of(l, 5)); if (i >= 256) break; f_attn_fox(A, l, (i & 15) >> 2, i & 3, 256 * (15 - (i >> 4))); }
            LAUNDER();
            for (;;) { const int i = q_next(c, qid_of(l, 6)); if (i >= 16) break; f_ret_scan(A, i); }
        }
        SEAM(pb + 3);
        if (IN_PH(pb + 4)) { f_select(A);
            LAUNDER();
            for (;;) { const int i = q_next(c, qid_of(l, 10)); if (i >= 256) break; f_attn_ret(A, l, (i & 15) >> 2, i & 3, 256 * (i >> 4)); } }
        SEAM(pb + 4);
        if (IN_PH(pb + 5)) {
            for (;;) { const int it = q_next(c, qid_of(l, 7)); if (it >= 256) break; f_attn_dsa(A, l, it & 3, 64 * (63 - (it >> 2))); }
            LAUNDER();
            { const int nb = cvt_early_nblk(l); for (;;) { const int it = q_next(c, qid_of(l, 8)); if (it >= nb) break; f_cvt_early(A, l, it); } }
            LAUNDER();
            f_gdn_fin(A, l);
        }
        SEAM(pb + 5);
        if (IN_PH(pb + 6)) f_gemm_merge(A);
        SEAM(pb + 6);
        if (IN_PH(pb + 7)) f_gemm_out(A);
        SEAM(pb + 7);
        if (IN_PH(pb + 9)) { f_gemm_gate(A, l); LAUNDER(); f_gemm_up(A, l); }
        SEAM(pb + 9);
        if (IN_PH(pb + 11)) f_gemm_down(A);
        SEAM(pb + 11);
    }
    if (IN_PH(PH_FINAL)) f_final(A);
#undef IN_PH
#undef SEAM
#undef A
}

extern "C" void kernel_launch(void* const* d_in, const int* in_sizes, int n_in, void* d_out, int out_size, void* d_ws, size_t ws_size, hipStream_t stream) {
    static int grid = 0;
    if (grid == 0) {
        if (n_in != 21 || out_size != M * D || ws_size < WS_END) { fprintf(stderr, "kernel_launch: unexpected sizes (n_in %d out %d ws %zu)\n", n_in, out_size, ws_size); grid = -1; return; }
        int dev = 0, cus = 0;
        if (hipGetDevice(&dev) != hipSuccess || hipDeviceGetAttribute(&cus, hipDeviceAttributeMultiprocessorCount, dev) != hipSuccess) { grid = -1; return; }
        if (hipFuncSetAttribute((const void*)fwd_kernel, hipFuncAttributeMaxDynamicSharedMemorySize, LDS_BYTES) != hipSuccess) { fprintf(stderr, "kernel_launch: hipFuncSetAttribute failed\n"); grid = -1; return; }
        int per_cu = 0;
        if (hipOccupancyMaxActiveBlocksPerMultiprocessor(&per_cu, (const void*)fwd_kernel, 512, LDS_BYTES) != hipSuccess || per_cu < 1) { fprintf(stderr, "kernel_launch: occupancy query says %d\n", per_cu); }
        (void)hipGetLastError();
        grid = cus;
    }
    if (grid < 0) return;
    (void)hipMemsetAsync((char*)d_ws + WS_CTL, 0, CTL_BYTES, stream);
    Params p{};
    for (int i = 0; i < 21; ++i) p.in[i] = (const float*)d_in[i];
    p.out = (float*)d_out; p.ws = (unsigned char*)d_ws;
    p.ph_lo = 0; p.ph_hi = N_PHASES;
    hipLaunchKernelGGL(fwd_kernel, dim3(grid), dim3(512), LDS_BYTES, stream, p);
}
```

```cpp
#include <hip/hip_runtime.h>
#include <cstdio>
#include <cstdint>

#define LAS __attribute__((address_space(3)))
typedef unsigned short bf16_t;
typedef short bf16x8 __attribute__((ext_vector_type(8)));
typedef short s16x4 __attribute__((ext_vector_type(4)));
typedef float f32x2 __attribute__((ext_vector_type(2)));
typedef float f32x4 __attribute__((ext_vector_type(4)));
typedef float f32x16 __attribute__((ext_vector_type(16)));
typedef unsigned u32x2 __attribute__((ext_vector_type(2)));
typedef unsigned u32x4 __attribute__((ext_vector_type(4)));
typedef __bf16 hbf2 __attribute__((ext_vector_type(2)));
#define DI __device__ __forceinline__

constexpr int D = 2048, BATCH = 4, SEQ = 4096, DEPTH = 4, M = BATCH * SEQ;
constexpr int NP = 14592, FF = 5632, NSRC = 14556;
constexpr float EPS = 1e-6f;
constexpr int C_RQ = 0, C_RK = 512, C_RV = 1024, C_RG = 1536, C_FQ = 2048, C_FK = 2560, C_FV = 3072, C_GQ = 3584, C_GK = 4096, C_GV = 4608, C_GZ = 5120,
              C_DCQ = 5632, C_DK = 6016, C_DV = 6144, C_IK = 6272, C_IW = 6336, C_FF = 6352, C_GB = 6356, C_GA = 6360, C_GATE = 6400;
__host__ __device__ constexpr int src_col(int j) {
    return j < 2048 ? j : j < 3584 ? 2768 + (j - 2048) : j < 5632 ? 4308 + (j - 3584) : j < 6352 ? 2048 + (j - 5632) : j < 6356 ? 4304 + (j - 6352)
         : j < 6364 ? j : j < 6400 ? -1 : 6364 + (j - 6400);
}
constexpr int O_RET = 0, O_DSA = 512, O_FOX = 1024, O_GDN = 1536;
constexpr int VT_ROWS = 1152, VT_RET = 0, VT_FOX = 512, VT_DSA = 1024;

constexpr size_t MiB = 1u << 20;
constexpr size_t WS_CTL = 0, CTL_BYTES = 128 * 1024;
constexpr size_t WS_ROPE = 1 * MiB;
constexpr size_t WS_BT = 3 * MiB;
constexpr size_t WS_WIN = 4 * MiB;
constexpr size_t WS_WG8 = 30 * MiB;
constexpr size_t WS_WBR = 61 * MiB;
constexpr size_t WS_WOUT = 69 * MiB;
constexpr size_t WS_WDSA = 77 * MiB;
constexpr size_t WS_H = 80 * MiB;
constexpr size_t WS_PROJ = 144 * MiB;
constexpr size_t WS_G = WS_PROJ, WS_ACT = WS_PROJ + 176 * MiB;
constexpr size_t WS_BR = 600 * MiB;
constexpr size_t WS_RQ = 664 * MiB, WS_RK = 680 * MiB;
constexpr int VT_LD = SEQ + 128, SC_LD = SEQ + 64;
constexpr size_t WS_VT = 696 * MiB;
constexpr size_t WS_QD = 734 * MiB;
constexpr size_t WS_SC = 782 * MiB;
constexpr size_t WS_WG = WS_SC, WS_WU = WS_SC + 22 * MiB, WS_WD = WS_SC + 44 * MiB;
constexpr size_t WS_MASK = 1042 * MiB;
constexpr size_t WS_U0 = 1050 * MiB;
constexpr size_t WS_KCUM = 1082 * MiB;
constexpr size_t WS_QDEC = 1098 * MiB;
constexpr size_t WS_KDT = 1114 * MiB;
constexpr size_t WS_QKM = 1130 * MiB;
constexpr size_t WS_OG = 1138 * MiB;
constexpr size_t WS_SMALL = 1170 * MiB;
constexpr size_t WS_CFOX = WS_SMALL, WS_RDSA = WS_SMALL + 256 * 1024, WS_EGL = WS_SMALL + 320 * 1024;
constexpr size_t WS_RSP1 = 1172 * MiB, WS_RSP2 = 1174 * MiB;
constexpr size_t WS_RF = 1176 * MiB;
constexpr size_t WS_XB8 = 1177 * MiB;
constexpr size_t WS_KVT = 1209 * MiB;
constexpr size_t WS_END = 1241 * MiB;
static_assert(WS_VT + (size_t)BATCH * 1152 * VT_LD * 2 <= WS_QD && WS_SC + (size_t)M * SC_LD * 4 <= WS_MASK, "ws map");

constexpr int CW_BAR = 4096;
constexpr int CW_Q = 16384;

constexpr int LDS_BYTES = 136 * 1024;
constexpr int LDS_MISC = 132 * 1024;

DI float bf2f(bf16_t v) { return __uint_as_float(((unsigned)v) << 16); }
DI unsigned pk2(float lo, float hi) { f32x2 v = {lo, hi}; hbf2 r = __builtin_convertvector(v, hbf2); return __builtin_bit_cast(unsigned, r); }
DI bf16_t f2bf(float f) { return (bf16_t)(pk2(f, 0.f) & 0xffffu); }
DI float lo_bf(unsigned w) { return __uint_as_float(w << 16); }
DI float hi_bf(unsigned w) { return __uint_as_float(w & 0xffff0000u); }
DI bf16x8 pack8(float a0, float a1, float a2, float a3, float a4, float a5, float a6, float a7) {
    u32x4 w = {pk2(a0, a1), pk2(a2, a3), pk2(a4, a5), pk2(a6, a7)}; return __builtin_bit_cast(bf16x8, w);
}
DI float wave_sum(float v) {
#pragma unroll
    for (int o = 1; o < 64; o <<= 1) v += __shfl_xor(v, o);
    return v;
}
DI float sigmoidf_(float x) { return __builtin_amdgcn_rcpf(1.f + __builtin_amdgcn_exp2f(x * -1.4426950408889634f)); }
DI float siluf_(float x) { return x * __builtin_amdgcn_rcpf(1.f + __builtin_amdgcn_exp2f(x * -1.4426950408889634f)); }
DI float silu_rcp(float x) { return x * __builtin_amdgcn_rcpf(1.f + __builtin_amdgcn_exp2f(x * -1.4426950408889634f)); }
typedef int v8i __attribute__((ext_vector_type(8)));
typedef int v4i __attribute__((ext_vector_type(4)));
DI unsigned pk4_fp8(float a, float b, float c_, float d) {
    a = fminf(fmaxf(a, -448.f), 448.f); b = fminf(fmaxf(b, -448.f), 448.f); c_ = fminf(fmaxf(c_, -448.f), 448.f); d = fminf(fmaxf(d, -448.f), 448.f);
    int p = 0; p = __builtin_amdgcn_cvt_pk_fp8_f32(a, b, p, false); p = __builtin_amdgcn_cvt_pk_fp8_f32(c_, d, p, true); return (unsigned)p; }
#define MFMA32(a, b, c) __builtin_amdgcn_mfma_f32_32x32x16_bf16((a), (b), (c), 0, 0, 0)
DI int crow(int r, int hf) { return (r & 3) + 8 * (r >> 2) + 4 * hf; }
DI void rs_factors8(const float* rf_, int row0, int  , float (&rf)[2][4]) {
#pragma unroll
    for (int ai = 0; ai < 2; ++ai)
#pragma unroll
        for (int m = 0; m < 4; ++m) rf[ai][m] = rf_[row0 + ai * 128 + m * 16];
}

#define XB_TMO      128
#define XB_XCNT(j)  (256  + 64 * (j))
#define XB_XSUB(j)  (1280 + 64 * (j))
#define XB_XGEN(j)  (2304 + 64 * (j))
#define XB_TOP      3328
#define XB_TOPGEN   3392
#define XCD_BAR_WORDS 3456
#define XB_SPIN_CAP (1u << 21)
__device__ __forceinline__ unsigned xb_ld(unsigned* p)              { return __hip_atomic_load(p, __ATOMIC_RELAXED, __HIP_MEMORY_SCOPE_AGENT); }
__device__ __forceinline__ unsigned xb_add(unsigned* p, unsigned v) { return __hip_atomic_fetch_add(p, v, __ATOMIC_RELAXED, __HIP_MEMORY_SCOPE_AGENT); }
__device__ __forceinline__ unsigned xb_xcc_id() { return (unsigned)__builtin_amdgcn_s_getreg((3 << 11) | 20) & 0xFu; }
#define XB_SPIN(cond, bar) do { unsigned _sp = 0; while (cond) { __builtin_amdgcn_s_sleep(1); \
    if ((++_sp & 255u) == 0u) { if (xb_ld(&(bar)[XB_TMO])) break; if (_sp > XB_SPIN_CAP) { atomicAdd(&(bar)[XB_TMO], 1u); break; } } } } while (0)
struct XcdBarrier { unsigned* bar; unsigned x; volatile LAS unsigned* st; };
__device__ __forceinline__ XcdBarrier xcd_barrier_post(unsigned* bar, volatile LAS unsigned* st) {
    XcdBarrier b; b.bar = bar; b.x = xb_xcc_id(); b.st = st;
    if (threadIdx.x == 0) (void)xb_add(&bar[XB_XCNT(b.x)], 1u);
    return b;
}
__device__ __forceinline__ void xcd_barrier_complete(unsigned* bar, unsigned x, unsigned& nloc, unsigned& nx) {
    const unsigned G = gridDim.x * gridDim.y * gridDim.z;
    unsigned sum, cnt, mine, sp = 0u;
    for (;;) {
        sum = 0u; cnt = 0u; mine = 0u;
#pragma unroll
        for (unsigned j = 0; j < 16; ++j) { const unsigned c = xb_ld(&bar[XB_XCNT(j)]); sum += c; cnt += (c > 0u) ? 1u : 0u; mine = (j == x) ? c : mine; }
        if (sum == G) break;
        __builtin_amdgcn_s_sleep(1);
        if ((++sp & 255u) == 0u) { if (xb_ld(&bar[XB_TMO])) break; if (sp > XB_SPIN_CAP) { atomicAdd(&bar[XB_TMO], 1u); break; } }
    }
    nloc = mine > 0u ? mine : 1u; nx = cnt > 0u ? cnt : 1u;
}
__device__ __forceinline__ void xcd_barrier(const XcdBarrier& b) {
    asm volatile("s_waitcnt vmcnt(0)" ::: "memory");
    __syncthreads();
    if (threadIdx.x == 0) {
        unsigned* bar = b.bar;
        __builtin_amdgcn_s_waitcnt(0);
        unsigned nloc = b.st[0], nx = b.st[1];
        if (nloc == 0u) { xcd_barrier_complete(bar, b.x, nloc, nx); b.st[0] = nloc; b.st[1] = nx; }
        const unsigned old = xb_add(&bar[XB_XSUB(b.x)], 1u);
        const unsigned gen = old / nloc;
        if (old + 1u == (gen + 1u) * nloc) {
            __builtin_amdgcn_fence(__ATOMIC_RELEASE, "agent");
            asm volatile("s_waitcnt vmcnt(0)" ::: "memory");
            const unsigned og = xb_add(&bar[XB_TOP], 1u);
            const unsigned tg = og / nx;
            if (og + 1u == (tg + 1u) * nx) xb_add(&bar[XB_TOPGEN], 1u);
            else XB_SPIN(xb_ld(&bar[XB_TOPGEN]) == tg, bar);
            __builtin_amdgcn_fence(__ATOMIC_ACQUIRE, "agent");
            xb_add(&bar[XB_XGEN(b.x)], 1u);
            asm volatile("s_waitcnt vmcnt(0)" ::: "memory");
        } else {
            XB_SPIN(xb_ld(&bar[XB_XGEN(b.x)]) == gen, bar);
            __builtin_amdgcn_fence(__ATOMIC_ACQUIRE, "agent");
            asm volatile("s_waitcnt vmcnt(0)" ::: "memory");
        }
    }
    __syncthreads();
}

namespace pg8 {
constexpr int BM = 256, BK = 64, HALF = 128, HTB = HALF * BK * 2, STAGE_BYTES = 8 * HTB, NXCD = 8, WGM = 8;
__host__ __device__ __forceinline__ int lds_byte(int r, int c) { const int st = (r >> 4) * 2 + (c >> 5), rr = r & 15, cc = c & 31, ob = rr * 64 + cc * 2; return st * 1024 + (ob ^ (((ob >> 9) & 1) << 5)); }
__host__ __device__ __forceinline__ void stage_rc(int b, int& R, int& C) { const int st = b / 1024, sb = b % 1024, swz = sb ^ (((sb >> 9) & 1) << 5); R = (st >> 1) * 16 + swz / 64; C = (st & 1) * 32 + (swz % 64) / 2; }
__host__ __device__ __forceinline__ int perm32(int rho) { const int n = rho >> 4, i = rho & 15; return 8 * (i >> 2) + 4 * n + (i & 3); }
struct Unit { int pm, pn, sub; };
struct Gemm { const bf16_t* A; const bf16_t* Bt; int lda, K; size_t subA, subB; };
struct Sched {
    int nM, nN, nwg, G, c, nsub;
    __device__ void init(int M_, int N_, int G_, int c_, int nsub_) { nM = M_ / BM; nN = N_ / BM; nwg = nM * nN; G = G_; c = c_; nsub = nsub_; }
    __device__ bool next(int i, Unit& u) const {
        const int ti = i / nsub; u.sub = i - ti * nsub;
        const long L = (long)ti * G + c; if (L >= nwg) return false;
        int wgid = (int)L; { const int q = nwg / NXCD, r = nwg % NXCD, xcd = wgid % NXCD, off = wgid / NXCD; wgid = (xcd < r ? xcd * (q + 1) : r * (q + 1) + (xcd - r) * q) + off; }
        const int nig = WGM * nN, gid = wgid / nig, fm = gid * WGM, gsz = (nM - fm) < WGM ? (nM - fm) : WGM;
        u.pm = fm + ((wgid % nig) % gsz); u.pn = (wgid % nig) / gsz; return true;
    }
};
template <class Epi, bool ALIGN_EPI = true, bool FP8 = false>
__device__ __forceinline__ void gemm_phase(LAS unsigned char* lds, const Gemm g, const Sched& S, const Epi& E, const int tid) {
    const int wid = __builtin_amdgcn_readfirstlane(tid >> 6), lane = tid & 63, wr = wid >> 2, wc = wid & 3, fr = lane & 15, fq = lane >> 4;
    const int K = g.K, nt = K / BK, lda = g.lda;
    unsigned voffA[2], voffB[2];
#pragma unroll
    for (int i = 0; i < 2; ++i) { int R, C; stage_rc(tid * 16 + i * 8192, R, C); const int Rb = Epi::PERM ? ((R & ~31) + perm32(R & 31)) : R;
        voffA[i] = (unsigned)(R * lda + C) * 2u; voffB[i] = (unsigned)(Rb * K + C) * 2u; }
    const size_t kstep = (size_t)(BK * 2);
    const size_t hstepA = (size_t)HALF * lda * 2, hstepB = (size_t)HALF * K * 2;
    const size_t tstepA = 2 * hstepA, tstepB = 2 * hstepB;
    const unsigned ldsw = (unsigned)wid * 1024u;
    const int aoff = lds_byte(wr * 64 + fr, fq * 8), boff = lds_byte(wc * 32 + fr, fq * 8);
#define PG8_SA(b, h) (((b) * 2 + (h)) * HTB)
#define PG8_SB(b, h) ((4 + (b) * 2 + (h)) * HTB)
#define PG8_STAGE(bufoff, gbase, voff) do { _Pragma("unroll") for (int _i = 0; _i < 2; ++_i) \
        __builtin_amdgcn_global_load_lds((const unsigned*)((const char*)(gbase) + (voff)[_i]), (LAS unsigned*)(lds + (bufoff) + ldsw + _i * 8192), 16, 0, 0); } while (0)
#define PG8_LD8(off) __builtin_shufflevector(*(const LAS v4i*)(lds + (off)), *(const LAS v4i*)(lds + (off) + 1024), 0, 1, 2, 3, 4, 5, 6, 7)
#define PG8_LDA(dst, b, h) do { if constexpr (FP8) { _Pragma("unroll") for (int m = 0; m < 4; ++m) dst##8[m] = PG8_LD8(PG8_SA(b, h) + aoff + m * 2048); } else { \
        _Pragma("unroll") for (int m = 0; m < 4; ++m) _Pragma("unroll") for (int k = 0; k < 2; ++k) dst[m][k] = *(const LAS bf16x8*)(lds + PG8_SA(b, h) + aoff + m * 2048 + k * 1024); } } while (0)
#define PG8_LDB(dst, b, h) do { if constexpr (FP8) { _Pragma("unroll") for (int n = 0; n < 2; ++n) dst##8[n] = PG8_LD8(PG8_SB(b, h) + boff + n * 2048); } else { \
        _Pragma("unroll") for (int n = 0; n < 2; ++n) _Pragma("unroll") for (int k = 0; k < 2; ++k) dst[n][k] = *(const LAS bf16x8*)(lds + PG8_SB(b, h) + boff + n * 2048 + k * 1024); } } while (0)
#define PG8_CAT(x, y) __builtin_shufflevector(__builtin_bit_cast(v4i, x), __builtin_bit_cast(v4i, y), 0, 1, 2, 3, 4, 5, 6, 7)
#define PG8_MMA(ai, bj, At, Bt) do { __builtin_amdgcn_s_setprio(1); _Pragma("unroll") for (int m = 0; m < 4; ++m) _Pragma("unroll") for (int n = 0; n < 2; ++n) { \
        if constexpr (FP8) asm volatile("v_mfma_f32_16x16x128_f8f6f4 %0, %1, %2, %0" : "+v"(acc[ai][bj][m][n]) : "v"(Bt##8[n]), "v"(At##8[m])); \
        else { _Pragma("unroll") for (int k = 0; k < 2; ++k) acc[ai][bj][m][n] = __builtin_amdgcn_mfma_f32_16x16x32_bf16(Bt[n][k], At[m][k], acc[ai][bj][m][n], 0, 0, 0); } } __builtin_amdgcn_s_setprio(0); } while (0)
#define PG8_WAIT_V(n) asm volatile("s_waitcnt vmcnt(" #n ")" ::: "memory")
#define PG8_WAIT_L(n) asm volatile("s_waitcnt lgkmcnt(" #n ")" ::: "memory")
#define PG8_BAR __builtin_amdgcn_s_barrier()
#define PG8_SCHED __builtin_amdgcn_sched_barrier(0)
    Unit cur, nxt; int ui = 0;
    if (!S.next(0, cur)) return;
    f32x4 acc[2][2][4][2];
#pragma unroll
    for (int a = 0; a < 2; ++a)
#pragma unroll
        for (int b = 0; b < 2; ++b)
#pragma unroll
            for (int m = 0; m < 4; ++m)
#pragma unroll
                for (int n = 0; n < 2; ++n) acc[a][b][m][n] = (f32x4){0.f, 0.f, 0.f, 0.f};
    bf16x8 At[4][2], B0[2][2], B1[2][2];
    v8i At8[4], B08[2], B18[2];
    const char* cA = (const char*)g.A + (size_t)cur.pm * tstepA + (size_t)cur.sub * g.subA; const char* cB = (const char*)g.Bt + (size_t)cur.pn * tstepB + (size_t)cur.sub * g.subB;
    PG8_STAGE(PG8_SB(0, 0), cB, voffB); PG8_STAGE(PG8_SB(0, 1), cB + hstepB, voffB); PG8_STAGE(PG8_SA(0, 0), cA, voffA); PG8_STAGE(PG8_SA(0, 1), cA + hstepA, voffA);
    if (wr == 1) PG8_BAR;
    PG8_WAIT_V(2); PG8_BAR;
    PG8_STAGE(PG8_SB(1, 0), cB + kstep, voffB); PG8_STAGE(PG8_SA(1, 0), cA + kstep, voffA); PG8_STAGE(PG8_SB(1, 1), cB + hstepB + kstep, voffB);
    PG8_WAIT_V(6); PG8_BAR;
    for (;;) {
        const bool has_next = S.next(ui + 1, nxt);
        const char* nA = has_next ? (const char*)g.A + (size_t)nxt.pm * tstepA + (size_t)nxt.sub * g.subA : cA;
        const char* nB = has_next ? (const char*)g.Bt + (size_t)nxt.pn * tstepB + (size_t)nxt.sub * g.subB : cB;
        for (int t = 0; t < nt; t += 2) {
            const bool last = (t == nt - 2);
            const char* a1 = cA + (size_t)(t + 1) * kstep;
            const char* a2 = last ? nA : cA + (size_t)(t + 2) * kstep; const char* b2 = last ? nB : cB + (size_t)(t + 2) * kstep;
            const char* a3 = a2 + kstep; const char* b3 = b2 + kstep;
            PG8_LDB(B0, 0, 0); PG8_LDB(B1, 0, 1); PG8_SCHED; PG8_LDA(At, 0, 0); PG8_STAGE(PG8_SA(1, 1), a1 + hstepA, voffA);
            PG8_WAIT_V(8); PG8_WAIT_L(0); PG8_BAR; PG8_MMA(0, 0, At, B0); PG8_MMA(0, 1, At, B1); PG8_BAR; PG8_SCHED;
            PG8_LDA(At, 0, 1); PG8_STAGE(PG8_SB(0, 0), b2, voffB); PG8_STAGE(PG8_SB(0, 1), b2 + hstepB, voffB); PG8_STAGE(PG8_SA(0, 0), a2, voffA);
            PG8_WAIT_V(8); PG8_WAIT_L(0); PG8_BAR; PG8_MMA(1, 0, At, B0); PG8_MMA(1, 1, At, B1); PG8_BAR; PG8_SCHED;
            PG8_LDB(B0, 1, 0); PG8_LDB(B1, 1, 1); PG8_SCHED; PG8_LDA(At, 1, 0); PG8_STAGE(PG8_SA(0, 1), a2 + hstepA, voffA);
            PG8_WAIT_V(8); PG8_WAIT_L(0); PG8_BAR; PG8_MMA(0, 0, At, B0); PG8_MMA(0, 1, At, B1); PG8_BAR; PG8_SCHED;
            PG8_LDA(At, 1, 1); PG8_STAGE(PG8_SB(1, 0), b3, voffB); PG8_STAGE(PG8_SB(1, 1), b3 + hstepB, voffB); PG8_STAGE(PG8_SA(1, 0), a3, voffA);
            PG8_WAIT_V(8); PG8_WAIT_L(0); PG8_BAR; PG8_MMA(1, 0, At, B0); PG8_MMA(1, 1, At, B1); PG8_BAR; PG8_SCHED;
        }
        if constexpr (ALIGN_EPI) { if (wr == 0) PG8_BAR; }
        if constexpr (FP8) asm volatile("s_nop 15\n\ts_nop 15" ::: "memory");
        E(acc, cur, wr, wc, fr, fq);
        if (!has_next) break;
        if (!(Epi::CHAIN && nxt.sub != 0)) {
#pragma unroll
        for (int a = 0; a < 2; ++a)
#pragma unroll
            for (int b = 0; b < 2; ++b)
#pragma unroll
                for (int m = 0; m < 4; ++m)
#pragma unroll
                    for (int n = 0; n < 2; ++n) acc[a][b][m][n] = (f32x4){0.f, 0.f, 0.f, 0.f};
        }
        cur = nxt; cA = nA; cB = nB; ++ui;
        if constexpr (ALIGN_EPI) { if (wr == 1) PG8_BAR; }
    }
    PG8_WAIT_V(0);
    if constexpr (!ALIGN_EPI) { if (wr == 0) PG8_BAR; }
    PG8_BAR;
#undef PG8_SA
#undef PG8_SB
#undef PG8_STAGE
#undef PG8_LDA
#undef PG8_LD8
#undef PG8_LDB
#undef PG8_MMA
#undef PG8_CAT
#undef PG8_WAIT_V
#undef PG8_WAIT_L
#undef PG8_BAR
#undef PG8_SCHED
}

struct EpiBf16 {
    static constexpr bool PERM = true, CHAIN = false;
    bf16_t* O; int ldc; const float* rs; int sig_pn; float oscale;
    __device__ __forceinline__ void operator()(f32x4 (&acc)[2][2][4][2], const Unit& u, int wr, int wc, int fr, int fq) const {
        const int row0 = u.pm * BM + wr * 64 + fr, col0 = u.pn * BM + wc * 32 + 8 * fq;
        const bool sg = u.pn >= sig_pn;
#pragma unroll
        for (int ai = 0; ai < 2; ++ai) {
            float rf4[4] = {1.f, 1.f, 1.f, 1.f};
            if (rs) {
#pragma unroll
                for (int m = 0; m < 4; ++m) rf4[m] = rs[row0 + ai * HALF + m * 16]; }
#pragma unroll
            for (int m = 0; m < 4; ++m) { const int row = row0 + ai * HALF + m * 16; bf16_t* rowp = O + (size_t)row * ldc + col0;
                const float r = rf4[m] * oscale;
#pragma unroll
                for (int bj = 0; bj < 2; ++bj) { f32x4 v0 = acc[ai][bj][m][0] * r, v1 = acc[ai][bj][m][1] * r;
                    if (sg) {
#pragma unroll
                        for (int q = 0; q < 4; ++q) { v0[q] = __builtin_amdgcn_rcpf(1.f + __expf(-v0[q])); v1[q] = __builtin_amdgcn_rcpf(1.f + __expf(-v1[q])); } }
                    u32x4 w; w.x = pk2(v0[0], v0[1]); w.y = pk2(v0[2], v0[3]); w.z = pk2(v1[0], v1[1]); w.w = pk2(v1[2], v1[3]);
                    *(u32x4*)(rowp + bj * HALF) = w; } }
        }
    }
};
struct EpiGate8 {
    static constexpr bool PERM = true, CHAIN = false;
    unsigned char* O; size_t ldb; const float* rs; float oscale;
    __device__ __forceinline__ void operator()(f32x4 (&acc)[2][2][4][2], const Unit& u, int wr, int wc, int fr, int fq) const {
        const int row0 = u.pm * BM + wr * 64 + fr, col0 = u.pn * BM + wc * 32 + 8 * fq;
#pragma unroll
        for (int ai = 0; ai < 2; ++ai) {
            float rf4[4];
#pragma unroll
            for (int m = 0; m < 4; ++m) rf4[m] = rs[row0 + ai * HALF + m * 16];
#pragma unroll
            for (int m = 0; m < 4; ++m) { const int row = row0 + ai * HALF + m * 16; unsigned char* rowp = O + (size_t)row * ldb + col0;
                const float r = rf4[m] * oscale * -1.4426950408889634f;
#pragma unroll
                for (int bj = 0; bj < 2; ++bj) { const f32x4 v0 = acc[ai][bj][m][0] * r, v1 = acc[ai][bj][m][1] * r;
                    unsigned w0 = 0u, w1 = 0u;
#pragma unroll
                    for (int q = 0; q < 4; ++q) {
                        const float s0 = fmaxf(__builtin_amdgcn_rcpf(fmaf(__builtin_amdgcn_exp2f(v0[q]), 1.f / 255.f, 1.f / 255.f)), 1.f), s1 = fmaxf(__builtin_amdgcn_rcpf(fmaf(__builtin_amdgcn_exp2f(v1[q]), 1.f / 255.f, 1.f / 255.f)), 1.f);
                        w0 = __builtin_amdgcn_cvt_pk_u8_f32(s0, q, w0); w1 = __builtin_amdgcn_cvt_pk_u8_f32(s1, q, w1); }
                    *(u32x2*)(rowp + bj * HALF) = (u32x2){w0, w1}; } }
        }
    }
};
struct EpiResid {
    static constexpr bool PERM = true, CHAIN = false;
    bf16_t* XB; int ldc; float* RS; unsigned char* XB8;
    __device__ __forceinline__ void operator()(f32x4 (&acc)[2][2][4][2], const Unit& u, int wr, int wc, int fr, int fq) const {
        const int row0 = u.pm * BM + wr * 64 + fr, col0 = u.pn * BM + wc * 32 + 8 * fq;
#pragma unroll
        for (int ai = 0; ai < 2; ++ai) {
            u32x4 xv[4][2];
#pragma unroll
            for (int m = 0; m < 4; ++m)
#pragma unroll
                for (int bj = 0; bj < 2; ++bj) xv[m][bj] = *(const u32x4*)(XB + (size_t)(row0 + ai * HALF + m * 16) * ldc + col0 + bj * HALF);
#pragma unroll
            for (int m = 0; m < 4; ++m) { const int row = row0 + ai * HALF + m * 16; float ss = 0.f;
#pragma unroll
                for (int bj = 0; bj < 2; ++bj) { const u32x4 x = xv[m][bj];
                    const f32x4 y0 = acc[ai][bj][m][0] + (f32x4){lo_bf(x.x), hi_bf(x.x), lo_bf(x.y), hi_bf(x.y)}, y1 = acc[ai][bj][m][1] + (f32x4){lo_bf(x.z), hi_bf(x.z), lo_bf(x.w), hi_bf(x.w)};
                    { u32x4 w; w.x = pk2(y0[0], y0[1]); w.y = pk2(y0[2], y0[3]); w.z = pk2(y1[0], y1[1]); w.w = pk2(y1[2], y1[3]); *(u32x4*)(XB + (size_t)row * ldc + col0 + bj * HALF) = w; }
                    if (XB8) { u32x2 w8; w8.x = pk4_fp8(y0[0], y0[1], y0[2], y0[3]); w8.y = pk4_fp8(y1[0], y1[1], y1[2], y1[3]); *(u32x2*)(XB8 + (size_t)row * ldc + col0 + bj * HALF) = w8; }
                    ss += ((y0[0] * y0[0] + y0[1] * y0[1]) + (y0[2] * y0[2] + y0[3] * y0[3])) + ((y1[0] * y1[0] + y1[1] * y1[1]) + (y1[2] * y1[2] + y1[3] * y1[3])); }
                if (RS) { ss += __shfl_xor(ss, 16); ss += __shfl_xor(ss, 32); if (fq == 0) RS[(size_t)row * 32 + u.pn * 4 + wc] = ss; } }
        }
    }
};
struct EpiUp {
    static constexpr bool PERM = true, CHAIN = false;
    bf16_t* O; const bf16_t* G; const float* cw; const float* cb; const float* rs;
    __device__ __forceinline__ void operator()(f32x4 (&acc)[2][2][4][2], const Unit& u, int wr, int wc, int fr, int fq) const {
        const int row0 = u.pm * BM + wr * 64 + fr, col0 = u.pn * BM + wc * 32 + 8 * fq;
#pragma unroll
        for (int bj = 0; bj < 2; ++bj) {
            const int col = col0 + bj * HALF;
            float w0[8], w1[8], w2[8], bb[8];
#pragma unroll
            for (int e = 0; e < 8; e += 4) { const f32x4 a = *(const f32x4*)(cw + col + e), b = *(const f32x4*)(cw + FF + col + e), c = *(const f32x4*)(cw + 2 * FF + col + e), d = *(const f32x4*)(cb + col + e);
#pragma unroll
                for (int q = 0; q < 4; ++q) { w0[e + q] = a[q]; w1[e + q] = b[q]; w2[e + q] = c[q]; bb[e + q] = d[q]; } }
#pragma unroll
            for (int ai = 0; ai < 2; ++ai) {
                u32x4 g[5];
                const int gbase = row0 - fr + ai * HALF;
                const int hb = (gbase & (SEQ - 1)) == 0 ? 0 : (fr >= 14 ? 16 - fr : 1);
                g[4] = *(const u32x4*)(G + (size_t)(gbase - hb) * FF + col);
#pragma unroll
                for (int m = 0; m < 4; ++m) g[m] = *(const u32x4*)(G + (size_t)(row0 + ai * HALF + m * 16) * FF + col);
#pragma unroll
                for (int m = 0; m < 4; ++m) {
                    const int row = row0 + ai * HALF + m * 16, t = row & (SEQ - 1);
                    const u32x4 cur = g[m], prv = g[m == 0 ? 4 : m - 1];
                    u32x4 h1, h0;
                    const unsigned live = ((row - fr) & (SEQ - 1)) ? ~0u : 0u, k1 = fr < 1 ? live : 0u, k2 = fr < 2 ? live : 0u;
#pragma unroll
                    for (int q = 0; q < 4; ++q) {
                        const int s1 = __builtin_amdgcn_mov_dpp((int)cur[q], 0x111, 0xf, 0xf, true), r1 = __builtin_amdgcn_mov_dpp((int)prv[q], 0x121, 0xf, 0xf, true);
                        const int s2 = __builtin_amdgcn_mov_dpp((int)cur[q], 0x112, 0xf, 0xf, true), r2 = __builtin_amdgcn_mov_dpp((int)prv[q], 0x122, 0xf, 0xf, true);
                        h1[q] = ((unsigned)r1 & k1) | (unsigned)s1; h0[q] = ((unsigned)r2 & k2) | (unsigned)s2; }
                    float r[8];
#pragma unroll
                    for (int q = 0; q < 4; ++q) {
                        const float c0 = w0[2 * q] * lo_bf(h0[q]) + w1[2 * q] * lo_bf(h1[q]) + w2[2 * q] * lo_bf(cur[q]) + bb[2 * q];
                        const float c1 = w0[2 * q + 1] * hi_bf(h0[q]) + w1[2 * q + 1] * hi_bf(h1[q]) + w2[2 * q + 1] * hi_bf(cur[q]) + bb[2 * q + 1];
                        r[2 * q] = silu_rcp(c0); r[2 * q + 1] = silu_rcp(c1);
                    }
                    const float rn = rs[row];
                    const f32x4 v0 = acc[ai][bj][m][0] * rn, v1 = acc[ai][bj][m][1] * rn;
                    u32x4 w; w.x = pk2(r[0] * v0[0], r[1] * v0[1]); w.y = pk2(r[2] * v0[2], r[3] * v0[3]); w.z = pk2(r[4] * v1[0], r[5] * v1[1]); w.w = pk2(r[6] * v1[2], r[7] * v1[3]);
                    *(u32x4*)(O + (size_t)row * FF + col) = w;
                }
            }
        }
    }
};
struct EpiMerge {
    static constexpr bool PERM = true, CHAIN = true;
    bf16_t* O; const bf16_t* P;
    __device__ __forceinline__ void operator()(f32x4 (&acc)[2][2][4][2], const Unit& u, int wr, int wc, int fr, int fq) const {
        const int row0 = u.pm * BM + wr * 64 + fr, col0 = u.pn * BM + wc * 32 + 8 * fq, n = u.sub;
#pragma unroll
        for (int ai = 0; ai < 2; ++ai) { constexpr int mb = 0;
            u32x2 ga[4][2], gb[4][2];
#pragma unroll
            for (int m = mb; m < mb + 4; ++m)
#pragma unroll
                for (int bj = 0; bj < 2; ++bj) {
                    const unsigned char* gp = (const unsigned char*)(P + (size_t)(row0 + ai * HALF + m * 16) * NP + C_GATE) + n * D + col0 + bj * HALF;
                    ga[m][bj] = *(const u32x2*)gp; gb[m][bj] = *(const u32x2*)(gp + (n < 3 ? D : 0)); }
#pragma unroll
            for (int m = mb; m < mb + 4; ++m) {
                const int row = row0 + ai * HALF + m * 16;
#pragma unroll
                for (int bj = 0; bj < 2; ++bj) {
                    const int col = col0 + bj * HALF;
                    float f[8];
#pragma unroll
                    for (int q = 0; q < 2; ++q) {
                        const unsigned a = ga[m][bj][q], b = gb[m][bj][q];
                        const float a0 = (float)(a & 255u), a1 = (float)((a >> 8) & 255u), a2 = (float)((a >> 16) & 255u), a3 = (float)(a >> 24);
                        if (n < 3) {
                            f[4 * q] = a0 * __builtin_amdgcn_rcpf((float)(b & 255u)); f[4 * q + 1] = a1 * __builtin_amdgcn_rcpf((float)((b >> 8) & 255u));
                            f[4 * q + 2] = a2 * __builtin_amdgcn_rcpf((float)((b >> 16) & 255u)); f[4 * q + 3] = a3 * __builtin_amdgcn_rcpf((float)(b >> 24));
                        } else { f[4 * q] = a0 * (1.f / 255.f); f[4 * q + 1] = a1 * (1.f / 255.f); f[4 * q + 2] = a2 * (1.f / 255.f); f[4 * q + 3] = a3 * (1.f / 255.f); }
                    }
                    f32x4 v0 = acc[ai][bj][m][0], v1 = acc[ai][bj][m][1];
                    v0[0] *= f[0]; v0[1] *= f[1]; v0[2] *= f[2]; v0[3] *= f[3]; v1[0] *= f[4]; v1[1] *= f[5]; v1[2] *= f[6]; v1[3] *= f[7];
                    if (n < 3) { acc[ai][bj][m][0] = v0; acc[ai][bj][m][1] = v1; }
                    else { u32x4 w; w.x = pk2(v0[0], v0[1]); w.y = pk2(v0[2], v0[3]); w.z = pk2(v1[0], v1[1]); w.w = pk2(v1[2], v1[3]);
                        *(u32x4*)(O + (size_t)row * D + col) = w; }
                }
            }
        }
    }
};
}
struct Params { const float* in[21]; float* out; unsigned char* ws; int ph_lo, ph_hi; };
enum { IN_X = 0, IN_NORM_MIX, IN_W_IN, IN_CQ_NORM, IN_W_UQ, IN_W_QIDX, IN_FOX_BIAS, IN_GDN_CONV, IN_GDN_ALOG, IN_GDN_DT, IN_GDN_NORM, IN_W_BRANCH, IN_W_OUT, IN_REL_BIAS,
       IN_NORM_FFN, IN_W_GATE, IN_W_UP, IN_FFN_CONV, IN_FFN_CONVB, IN_W_DOWN, IN_FINAL_NORM };
struct Ctx {
    LAS unsigned char* lds; volatile LAS unsigned* misc; unsigned* ctl; unsigned char* ws;
    int tid, lane, wave, G, bid;
    const LAS unsigned long long* inl; float* out;
};
#define INP(i) ((const float*)c.inl[(i)])
#define WSP(T, off) ((T*)(c.ws + (off)))

DI int q_next(const Ctx& c, int qid) {
    __syncthreads();
    if (c.tid == 0) c.misc[0] = __hip_atomic_fetch_add(c.ctl + CW_Q + 64 * qid, 1u, __ATOMIC_RELAXED, __HIP_MEMORY_SCOPE_AGENT);
    __syncthreads();
    return (int)c.misc[0];
}

template <bool MAP>
DI void cvt_item(const float* W, int K, int N, bf16_t* WT, int nblk, const float* kscale, LAS float*  , int item, int lane) {
    const int kb = item / nblk, nb = item % nblk, k0 = 64 * kb, n0 = 64 * nb;
    const int n = n0 + lane; const int sc = MAP ? src_col(n) : n;
    const int scc = sc >= 0 ? sc : 0; const float live = sc >= 0 ? 1.f : 0.f;
    const float* src = W + (size_t)k0 * N + scc;
    float v[64];
#pragma unroll
    for (int i = 0; i < 64; ++i) v[i] = src[(size_t)i * N];
    if (kscale) {
#pragma unroll
        for (int i = 0; i < 64; ++i) v[i] *= kscale[k0 + i]; }
    bf16_t* dst = WT + (size_t)n * K + k0;
#pragma unroll
    for (int q = 0; q < 8; ++q) { u32x4 o; o.x = pk2(v[8 * q] * live, v[8 * q + 1] * live); o.y = pk2(v[8 * q + 2] * live, v[8 * q + 3] * live); o.z = pk2(v[8 * q + 4] * live, v[8 * q + 5] * live); o.w = pk2(v[8 * q + 6] * live, v[8 * q + 7] * live);
        *(u32x4*)(dst + 8 * q) = o; }
}
DI void cvt_item_gate8(const float* W, const float* gain, unsigned char* W8, int item, int lane) {
    constexpr int nblk = 8192 / 64; const int kb = item / nblk, nb = item % nblk, k0 = 64 * kb, n = 64 * nb + lane;
    const float* src = W + (size_t)k0 * NSRC + (6364 + n);
    float v[64];
#pragma unroll
    for (int i = 0; i < 64; ++i) v[i] = src[(size_t)i * NSRC];
#pragma unroll
    for (int i = 0; i < 64; ++i) v[i] *= gain[k0 + i] * 128.f;
    unsigned char* dst = W8 + (size_t)n * D + k0;
#pragma unroll
    for (int q = 0; q < 4; ++q) { u32x4 o; o.x = pk4_fp8(v[16 * q], v[16 * q + 1], v[16 * q + 2], v[16 * q + 3]); o.y = pk4_fp8(v[16 * q + 4], v[16 * q + 5], v[16 * q + 6], v[16 * q + 7]);
        o.z = pk4_fp8(v[16 * q + 8], v[16 * q + 9], v[16 * q + 10], v[16 * q + 11]); o.w = pk4_fp8(v[16 * q + 12], v[16 * q + 13], v[16 * q + 14], v[16 * q + 15]); *(u32x4*)(dst + 16 * q) = o; }
}
constexpr int CI_INB = (D / 64) * (C_GATE / 64), CI_ING = (D / 64) * (8192 / 64), CI_IN = CI_INB + CI_ING, CI_BR = (512 / 64) * (D / 64), CI_OUT = (D / 64) * (D / 64), CI_UQ = (384 / 64) * (512 / 64), CI_QI = (384 / 64) * (1024 / 64);
constexpr int CI_G = (D / 64) * (FF / 64), CI_D = (FF / 64) * (D / 64);
constexpr int CI_FFN = 2 * CI_G + CI_D, CI_EARLY_MIX = CI_IN + CI_UQ + CI_QI, CI_LATE = 4 * CI_BR + CI_OUT;
DI void cvt_ffn_item(const Ctx& c, int l, int r, LAS float* scr) {
    const float* wg = INP(IN_W_GATE) + (size_t)l * D * FF; const float* wu = INP(IN_W_UP) + (size_t)l * D * FF; const float* wd = INP(IN_W_DOWN) + (size_t)l * FF * D;
    const float* gf = INP(IN_NORM_FFN) + (size_t)l * D;
    if (r < CI_G) { cvt_item<false>(wg, D, FF, WSP(bf16_t, WS_WG), FF / 64, gf, scr, r, c.lane); return; } r -= CI_G;
    if (r < CI_G) { cvt_item<false>(wu, D, FF, WSP(bf16_t, WS_WU), FF / 64, gf, scr, r, c.lane); return; } r -= CI_G;
    cvt_item<false>(wd, FF, D, WSP(bf16_t, WS_WD), D / 64, nullptr, scr, r, c.lane);
}
DI void cvt_early_mix_item(const Ctx& c, int l, int r, LAS float* scr) {
    const float* w_in = INP(IN_W_IN) + (size_t)l * D * NSRC; const float* w_uq = INP(IN_W_UQ) + (size_t)l * 384 * 512; const float* w_qi = INP(IN_W_QIDX) + (size_t)l * 384 * 1024;
    const float* cqg = INP(IN_CQ_NORM) + (size_t)l * 384;
    if (r < CI_INB) { cvt_item<true>(w_in, D, NSRC, WSP(bf16_t, WS_WIN), C_GATE / 64, INP(IN_NORM_MIX) + (size_t)l * D, scr, r, c.lane); return; } r -= CI_INB;
    if (r < CI_ING) { cvt_item_gate8(w_in, INP(IN_NORM_MIX) + (size_t)l * D, WSP(unsigned char, WS_WG8), r, c.lane); return; } r -= CI_ING;
    if (r < CI_UQ) { cvt_item<false>(w_uq, 384, 512, WSP(bf16_t, WS_WDSA), 512 / 64, cqg, scr, r, c.lane); return; } r -= CI_UQ;
    cvt_item<false>(w_qi, 384, 1024, WSP(bf16_t, WS_WDSA) + (size_t)512 * 384, 1024 / 64, cqg, scr, r, c.lane);
}
DI void cvt_late_item(const Ctx& c, int l, int r, LAS float* scr) {
    const float* w_br = INP(IN_W_BRANCH) + (size_t)l * 4 * 512 * D; const float* w_out = INP(IN_W_OUT) + (size_t)l * D * D;
    if (r < 4 * CI_BR) { const int n = r / CI_BR; cvt_item<false>(w_br + (size_t)n * 512 * D, 512, D, WSP(bf16_t, WS_WBR) + (size_t)n * D * 512, D / 64, nullptr, scr, r % CI_BR, c.lane); return; } r -= 4 * CI_BR;
    cvt_item<false>(w_out, D, D, WSP(bf16_t, WS_WOUT), D / 64, nullptr, scr, r, c.lane);
}
DI int cvt_early_nblk(int l) { return (CI_FFN + (l + 1 < DEPTH ? CI_EARLY_MIX : 0) + 31) / 32; }
DI void cvt_early_block(const Ctx& c, int l, int blk) {
    LAS float* scr = (LAS float*)(c.lds + c.wave * 16384);
    const int tot = CI_FFN + (l + 1 < DEPTH ? CI_EARLY_MIX : 0);
    __syncthreads();
    for (int k = 0; k < 4; ++k) { const int it = blk * 32 + c.wave * 4 + k; if (it >= tot) break;
        if (it < CI_FFN) cvt_ffn_item(c, l, it, scr); else cvt_early_mix_item(c, l + 1, it - CI_FFN, scr); }
    __syncthreads();
}
DI void cvt_late_all(const Ctx& c, int l) {
    LAS float* scr = (LAS float*)(c.lds + c.wave * 16384);
    const int gw = c.bid * 8 + c.wave, NGW = c.G * 8;
    for (int it = gw; it < CI_LATE; it += NGW) cvt_late_item(c, l, it, scr);
}
DI void cvt_mixer0(const Ctx& c) {
    LAS float* scr = (LAS float*)(c.lds + c.wave * 16384);
    const int gw = c.bid * 8 + c.wave, NGW = c.G * 8;
    for (int it = gw; it < CI_EARLY_MIX + CI_LATE; it += NGW) { if (it < CI_EARLY_MIX) cvt_early_mix_item(c, 0, it, scr); else cvt_late_item(c, 0, it - CI_EARLY_MIX, scr); }
}
DI void make_tables(const Ctx& c) {
    float* cs = WSP(float, WS_ROPE); float* sn = cs + SEQ * 64;
    for (int e = c.bid * 512 + c.tid; e < SEQ * 64; e += c.G * 512) {
        const int pos = e >> 6, i = e & 63;
        const float inv = 1.f / exp2f((float)i * (13.287712379549449f / 64.f));
        const float ang = (float)pos * inv;
        cs[e] = cosf(ang); sn[e] = sinf(ang);
    }
    if (c.bid == 0) {
        float* bt = WSP(float, WS_BT); const float* rb = INP(IN_REL_BIAS);
        for (int e = c.tid; e < 4 * 128 + 4; e += 512) {
            int h, rel; if (e < 512) { h = e >> 7; rel = e & 127; } else { h = e - 512; rel = 128; }
            int bk;
            if (rel < 16) bk = rel; else { const float lf = logf((float)rel / 16.f) / 2.0794415416798357f * 16.f; bk = 16 + (int)lf; if (bk > 31) bk = 31; }
            bt[e] = rb[bk * 4 + h];
        }
    }
}

DI void rmsnorm_rows(const Ctx& c, const float* x, const float* gain, bf16_t* dst, float* copy) {
    const int gw = c.bid * 8 + c.wave, NGW = c.G * 8;
    f32x4 gv[8];
#pragma unroll
    for (int j = 0; j < 8; ++j) gv[j] = *((const f32x4*)gain + c.lane + 64 * j);
    for (int m = gw; m < M; m += NGW) {
        const f32x4* xr = (const f32x4*)(x + (size_t)m * D) + c.lane;
        f32x4 v[8]; float s = 0.f;
#pragma unroll
        for (int j = 0; j < 8; ++j) { v[j] = xr[64 * j]; s += (v[j].x * v[j].x + v[j].y * v[j].y) + (v[j].z * v[j].z + v[j].w * v[j].w); }
        const float r = rsqrtf(wave_sum(s) * (1.f / D) + EPS);
        u32x2* o = (u32x2*)(dst + (size_t)m * D) + c.lane;
#pragma unroll
        for (int j = 0; j < 8; ++j) { u32x2 w; w.x = pk2(v[j].x * r * gv[j].x, v[j].y * r * gv[j].y); w.y = pk2(v[j].z * r * gv[j].z, v[j].w * r * gv[j].w); o[64 * j] = w; }
        if (copy) { f32x4* cp = (f32x4*)(copy + (size_t)m * D) + c.lane;
#pragma unroll
            for (int j = 0; j < 8; ++j) cp[64 * j] = v[j]; }
    }
}
DI void x0_rows(const Ctx& c, const float* x, bf16_t* xb, float* rs, unsigned char* xb8) {
    const int gw = c.bid * 8 + c.wave, NGW = c.G * 8;
    for (int m = gw; m < M; m += NGW) {
        const f32x4* xr = (const f32x4*)(x + (size_t)m * D) + c.lane;
        f32x4 v[8]; float s = 0.f;
#pragma unroll
        for (int j = 0; j < 8; ++j) { v[j] = xr[64 * j]; s += (v[j].x * v[j].x + v[j].y * v[j].y) + (v[j].z * v[j].z + v[j].w * v[j].w); }
        s = wave_sum(s); if (c.lane < 32) rs[(size_t)m * 32 + c.lane] = c.lane == 0 ? s : 0.f;
        u32x2* o = (u32x2*)(xb + (size_t)m * D) + c.lane;
#pragma unroll
        for (int j = 0; j < 8; ++j) { u32x2 w; w.x = pk2(v[j].x, v[j].y); w.y = pk2(v[j].z, v[j].w); o[64 * j] = w;
            ((unsigned*)(xb8 + (size_t)m * D))[c.lane + 64 * j] = pk4_fp8(v[j].x, v[j].y, v[j].z, v[j].w); }
    }
}
DI void row_factors(const Ctx& c, const float* rsp, float* rf) {
    for (int row = c.bid * 512 + c.tid; row < M; row += c.G * 512) {
        const f32x4* p = (const f32x4*)(rsp + (size_t)row * 32); float s = 0.f;
#pragma unroll
        for (int q = 0; q < 8; ++q) { const f32x4 v = p[q]; s += (v[0] + v[1]) + (v[2] + v[3]); }
        rf[row] = rsqrtf(s * (1.f / D) + EPS);
    }
}
template <class SchedT>
DI void row_factors_units(const Ctx& c, const float* rsp, float* rf, const SchedT& S, int& last_pm) {
    pg8::Unit u;
    for (int i = 0; S.next(i, u); ++i) {
        if (u.pm == last_pm) continue;
        last_pm = u.pm;
        const int row = u.pm * 256 + (c.tid >> 1);
        const f32x4* p = (const f32x4*)(rsp + (size_t)row * 32 + 16 * (c.tid & 1)); float s = 0.f;
#pragma unroll
        for (int q = 0; q < 4; ++q) { const f32x4 v = p[q]; s += (v[0] + v[1]) + (v[2] + v[3]); }
        s += __shfl_xor(s, 1);
        if (!(c.tid & 1)) rf[row] = rsqrtf(s * (1.f / D) + EPS);
    }
    __syncthreads();
}
DI void final_norm(const Ctx& c, float* x, const float* gain, const float fac = 1.f) {
    const int gw = c.bid * 8 + c.wave, NGW = c.G * 8;
    f32x4 gv[8];
#pragma unroll
    for (int j = 0; j < 8; ++j) gv[j] = *((const f32x4*)gain + c.lane + 64 * j);
    for (int m = gw; m < M; m += NGW) {
        f32x4* xr = (f32x4*)(x + (size_t)m * D) + c.lane;
        f32x4 v[8]; float s = 0.f;
#pragma unroll
        for (int j = 0; j < 8; ++j) { v[j] = xr[64 * j]; s += (v[j].x * v[j].x + v[j].y * v[j].y) + (v[j].z * v[j].z + v[j].w * v[j].w); }
        const float r = rsqrtf(wave_sum(s) * (1.f / D) + EPS) * fac;
#pragma unroll
        for (int j = 0; j < 8; ++j) xr[64 * j] = v[j] * r * gv[j];
    }
}
DI void final_norm_bf(const Ctx& c, const bf16_t* xb, float* out, const float* gain) {
    const int gw = c.bid * 8 + c.wave, NGW = c.G * 8;
    f32x4 gv[8];
#pragma unroll
    for (int j = 0; j < 8; ++j) gv[j] = *((const f32x4*)gain + c.lane + 64 * j);
    for (int m = gw; m < M; m += NGW) {
        const u32x2* xr = (const u32x2*)(xb + (size_t)m * D) + c.lane;
        f32x4 v[8]; float s = 0.f;
#pragma unroll
        for (int j = 0; j < 8; ++j) { const u32x2 w = xr[64 * j]; v[j] = (f32x4){lo_bf(w.x), hi_bf(w.x), lo_bf(w.y), hi_bf(w.y)}; s += (v[j].x * v[j].x + v[j].y * v[j].y) + (v[j].z * v[j].z + v[j].w * v[j].w); }
        const float r = rsqrtf(wave_sum(s) * (1.f / D) + EPS);
        f32x4* o = (f32x4*)(out + (size_t)m * D) + c.lane;
#pragma unroll
        for (int j = 0; j < 8; ++j) o[64 * j] = v[j] * r * gv[j];
    }
}

DI void prep_tokens(const Ctx& c, int item) {
    const int row0 = item * 64, b = row0 / SEQ, s0 = row0 % SEQ;
    const bf16_t* P = WSP(bf16_t, WS_PROJ);
    { const float* cs = WSP(float, WS_ROPE); const float* sn = cs + SEQ * 64; bf16_t* RQ = WSP(bf16_t, WS_RQ); bf16_t* RK = WSP(bf16_t, WS_RK);
#pragma unroll 2
      for (int k = 0; k < 8; ++k) { const int e = c.tid + 512 * k;
        const int i8 = e & 7, head = (e >> 3) & 3, which = (e >> 5) & 1, tok = e >> 6;
        const int row = row0 + tok, pos = s0 + tok;
        const bf16_t* src = P + (size_t)row * NP + (which ? C_RK : C_RQ) + head * 128 + 8 * i8;
        const u32x4 a = *(const u32x4*)src, bq = *(const u32x4*)(src + 64);
        const f32x4 c0 = *(const f32x4*)(cs + pos * 64 + 8 * i8), c1 = *(const f32x4*)(cs + pos * 64 + 8 * i8 + 4), s0v = *(const f32x4*)(sn + pos * 64 + 8 * i8), s1v = *(const f32x4*)(sn + pos * 64 + 8 * i8 + 4);
        float x1[8], x2[8], co[8], si[8];
#pragma unroll
        for (int q = 0; q < 4; ++q) { x1[2 * q] = lo_bf(a[q]); x1[2 * q + 1] = hi_bf(a[q]); x2[2 * q] = lo_bf(bq[q]); x2[2 * q + 1] = hi_bf(bq[q]); co[q] = c0[q]; co[4 + q] = c1[q]; si[q] = s0v[q]; si[4 + q] = s1v[q]; }
        u32x4 o1, o2;
#pragma unroll
        for (int q = 0; q < 4; ++q) { o1[q] = pk2(x1[2 * q] * co[2 * q] - x2[2 * q] * si[2 * q], x1[2 * q + 1] * co[2 * q + 1] - x2[2 * q + 1] * si[2 * q + 1]);
            o2[q] = pk2(x1[2 * q] * si[2 * q] + x2[2 * q] * co[2 * q], x1[2 * q + 1] * si[2 * q + 1] + x2[2 * q + 1] * co[2 * q + 1]); }
        bf16_t* dst = (which ? RK : RQ) + (size_t)row * 512 + head * 128 + 8 * i8;
        *(u32x4*)dst = o1; *(u32x4*)(dst + 64) = o2;
      } }
    { const int tok = c.tid >> 3, part = c.tid & 7;
      const bf16_t* src = P + (size_t)(row0 + tok) * NP + C_DCQ + part * 48; float s = 0.f;
#pragma unroll
      for (int j = 0; j < 6; ++j) { const u32x4 w = *(const u32x4*)(src + 8 * j);
#pragma unroll
          for (int q = 0; q < 4; ++q) { const float a = lo_bf(w[q]), bb = hi_bf(w[q]); s += a * a + bb * bb; } }
      s += __shfl_xor(s, 1); s += __shfl_xor(s, 2); s += __shfl_xor(s, 4);
      if (part == 0) WSP(float, WS_RDSA)[row0 + tok] = rsqrtf(s * (1.f / 384.f) + EPS); }
    LAS bf16_t* tile = (LAS bf16_t*)c.lds;
    bf16_t* VT = WSP(bf16_t, WS_VT);
#pragma unroll
    for (int rd = 0; rd < 2; ++rd) {
        const int nch = rd == 0 ? 5 : 4, ch0 = rd == 0 ? 0 : 5;
        u32x4 w[10];
#pragma unroll
        for (int q = 0; q < 10; ++q) if (q < 2 * nch) { const int chn = ch0 + (q >> 1); const int scol = chn < 4 ? C_RV + 128 * chn : chn < 8 ? C_FV + 128 * (chn - 4) : C_DV;
            const int idx = c.tid + 512 * (q & 1), r = idx >> 4, ch = idx & 15; w[q] = *(const u32x4*)(P + (size_t)(row0 + r) * NP + scol + ch * 8); }
        __syncthreads();
#pragma unroll
        for (int q = 0; q < 10; ++q) if (q < 2 * nch) { const int idx = c.tid + 512 * (q & 1), r = idx >> 4, ch = idx & 15;
            LAS unsigned* d = (LAS unsigned*)(tile + r * 642 + (q >> 1) * 128 + ch * 8); d[0] = w[q].x; d[1] = w[q].y; d[2] = w[q].z; d[3] = w[q].w; }
        __syncthreads();
#pragma unroll
        for (int q = 0; q < 10; ++q) if (q < 2 * nch) { const int chn = ch0 + (q >> 1); const int vrow = chn < 4 ? VT_RET + 128 * chn : chn < 8 ? VT_FOX + 128 * (chn - 4) : VT_DSA;
            const int idx = c.tid + 512 * (q & 1), col = idx >> 3, tg = idx & 7;
            unsigned short v[8];
#pragma unroll
            for (int e = 0; e < 8; ++e) v[e] = tile[(8 * tg + e) * 642 + (q >> 1) * 128 + col];
            u32x4 o; o.x = v[0] | ((unsigned)v[1] << 16); o.y = v[2] | ((unsigned)v[3] << 16); o.z = v[4] | ((unsigned)v[5] << 16); o.w = v[6] | ((unsigned)v[7] << 16);
            *(u32x4*)(VT + ((size_t)(b * VT_ROWS + vrow + col)) * VT_LD + s0 + 8 * tg) = o; }
    }
    __syncthreads();
}
DI void prep_cfox(const Ctx& c, int item, int l) {
    const int b = item >> 2, h = item & 3;
    const bf16_t* P = WSP(bf16_t, WS_PROJ); const float fb = INP(IN_FOX_BIAS)[l * 4 + h];
    float v[8]; float run = 0.f;
#pragma unroll
    for (int j = 0; j < 8; ++j) { const float x = bf2f(P[(size_t)(b * SEQ + c.tid * 8 + j) * NP + C_FF + h]) + fb;
        const float ls = fminf(x, 0.f) - __logf(1.f + __expf(-fabsf(x))); run += ls; v[j] = run; }
    float tot = run;
#pragma unroll
    for (int o = 1; o < 64; o <<= 1) { const float t = __shfl_up(tot, o); if (c.lane >= o) tot += t; }
    LAS float* wt = (LAS float*)c.lds;
    __syncthreads();
    if (c.lane == 63) wt[c.wave] = tot;
    __syncthreads();
    float pre = tot - run;
    for (int w = 0; w < c.wave; ++w) pre += wt[w];
    float* dst = WSP(float, WS_CFOX) + (size_t)(b * 4 + h) * SEQ + c.tid * 8;
#pragma unroll
    for (int j = 0; j < 8; ++j) dst[j] = pre + v[j];
    __syncthreads();
}
DI void gdn_finish(const Ctx& c, int l) {
    const int gw = c.bid * 8 + c.wave, NGW = c.G * 8;
    const float* OG = WSP(float, WS_OG); const bf16_t* P = WSP(bf16_t, WS_PROJ); bf16_t* BR = WSP(bf16_t, WS_BR);
    const float* ng = INP(IN_GDN_NORM) + l * 128 + ((8 * c.lane) & 127);
    const f32x4 g0 = *(const f32x4*)ng, g1 = *(const f32x4*)(ng + 4);
    for (int m = gw; m < M; m += NGW) {
        const f32x4 a = *(const f32x4*)(OG + (size_t)m * 512 + 8 * c.lane), bq = *(const f32x4*)(OG + (size_t)m * 512 + 8 * c.lane + 4);
        float s = (a.x * a.x + a.y * a.y) + (a.z * a.z + a.w * a.w) + (bq.x * bq.x + bq.y * bq.y) + (bq.z * bq.z + bq.w * bq.w);
        s += __shfl_xor(s, 1); s += __shfl_xor(s, 2); s += __shfl_xor(s, 4); s += __shfl_xor(s, 8);
        const float r = rsqrtf(s * (1.f / 128.f) + EPS);
        const u32x4 z = *(const u32x4*)(P + (size_t)m * NP + C_GZ + 8 * c.lane);
        u32x4 w;
        w.x = pk2(a.x * r * g0.x * siluf_(lo_bf(z.x)), a.y * r * g0.y * siluf_(hi_bf(z.x)));
        w.y = pk2(a.z * r * g0.z * siluf_(lo_bf(z.y)), a.w * r * g0.w * siluf_(hi_bf(z.y)));
        w.z = pk2(bq.x * r * g1.x * siluf_(lo_bf(z.z)), bq.y * r * g1.y * siluf_(hi_bf(z.z)));
        w.w = pk2(bq.z * r * g1.z * siluf_(lo_bf(z.w)), bq.w * r * g1.w * siluf_(hi_bf(z.w)));
        *(u32x4*)(BR + (size_t)m * D + O_GDN + 8 * c.lane) = w;
    }
}
enum { AT_FOX = 0, AT_RET = 1, AT_DSA = 2 };
constexpr int AT_KSTR = 272, AT_VSTR = 136;
constexpr int AT_KBYTES = 64 * AT_KSTR, AT_VBYTES = 128 * AT_VSTR;
constexpr int AT_BUF = AT_KBYTES + AT_VBYTES + 256;
constexpr int AT_TAB = 2 * AT_BUF;
constexpr float SM_SCALE = 0.08838834764831845f, LOG2E = 1.4426950408889634f;

template <int MODE>
DI void attn_unit(const Ctx& c, int l, int b, int hh, int q0) {
    LAS unsigned char* lds = c.lds;
    const int tid = c.tid, w = c.wave, lane = c.lane, l31 = lane & 31, hf = lane >> 5;
    const int head = (MODE == AT_DSA) ? (w >> 1) : hh;
    const int qw0 = q0 + ((MODE == AT_DSA) ? 32 * (w & 1) : 32 * w);
    const int t = qw0 + l31;
    constexpr int QR = (MODE == AT_DSA) ? 64 : 256;
    const int nkt = (q0 + QR) / 64;
    const bf16_t* P = WSP(bf16_t, WS_PROJ);
    const bf16_t* Qb; int ldq; const bf16_t* Kb; int ldk; int vrow0, ocol;
    if (MODE == AT_FOX) { Qb = P + C_FQ + head * 128; ldq = NP; Kb = P + C_FK + head * 128; ldk = NP; vrow0 = VT_FOX + head * 128; ocol = O_FOX + head * 128; }
    else if (MODE == AT_RET) { Qb = WSP(bf16_t, WS_RQ) + head * 128; ldq = 512; Kb = WSP(bf16_t, WS_RK) + head * 128; ldk = 512; vrow0 = VT_RET + head * 128; ocol = O_RET + head * 128; }
    else { Qb = WSP(bf16_t, WS_QD) + head * 128; ldq = 1536; Kb = P + C_DK; ldk = NP; vrow0 = VT_DSA; ocol = O_DSA + head * 128; }
    const bf16_t* VTb = WSP(bf16_t, WS_VT) + (size_t)(b * VT_ROWS + vrow0) * VT_LD;
    const float* cf = WSP(float, WS_CFOX) + (size_t)(b * 4 + head) * SEQ;

    bf16x8 qf[8];
    { const bf16_t* qp = Qb + (size_t)(b * SEQ + t) * ldq + 8 * hf;
#pragma unroll
      for (int s = 0; s < 8; ++s) qf[s] = *(const bf16x8*)(qp + 16 * s); }
    float xscale = SM_SCALE * LOG2E, cq = 0.f, lg = 0.f;
    if (MODE == AT_DSA) xscale = SM_SCALE * LOG2E * WSP(float, WS_RDSA)[b * SEQ + t];
    if (MODE == AT_RET) { lg = log2f(1.f - exp2f(-5.f - (float)head)); xscale = SM_SCALE; }
    const unsigned long long* mrow = WSP(unsigned long long, WS_MASK) + (size_t)(b * SEQ + t) * 64;
    LAS float* tab = (LAS float*)(lds + AT_TAB);
    __syncthreads();
    if (MODE == AT_RET) { if (tid < 64) tab[tid] = exp2f(lg * (float)(63 - tid)); }
    if (MODE == AT_DSA) { const float* bt = WSP(float, WS_BT); for (int e = tid; e < 516; e += 512) tab[e] = bt[e] * LOG2E; }

    u32x4 kreg[2], vreg[2]; float creg = 0.f; unsigned long long mreg = 0ull, mcur = 0ull;
    auto issue = [&](int j) {
#pragma unroll
        for (int p = 0; p < 2; ++p) { const int idx = tid + 512 * p;
            kreg[p] = *(const u32x4*)(Kb + (size_t)(b * SEQ + 64 * j + (idx >> 4)) * ldk + (idx & 15) * 8);
            vreg[p] = *(const u32x4*)(VTb + (size_t)(idx >> 3) * VT_LD + 64 * j + (idx & 7) * 8); }
        if (MODE == AT_FOX) creg = cf[64 * j + (tid & 63)];
        if (MODE == AT_DSA) mreg = mrow[j];
    };
    auto commit = [&](int buf) {
        LAS unsigned char* kb = lds + buf * AT_BUF; LAS unsigned char* vb = kb + AT_KBYTES;
#pragma unroll
        for (int p = 0; p < 2; ++p) { const int idx = tid + 512 * p;
            *(LAS u32x4*)(kb + (idx >> 4) * AT_KSTR + (idx & 15) * 16) = kreg[p];
            LAS u32x2* vd = (LAS u32x2*)(vb + (idx >> 3) * AT_VSTR + (idx & 7) * 16);
            vd[0] = (u32x2){vreg[p].x, vreg[p].y}; vd[1] = (u32x2){vreg[p].z, vreg[p].w}; }
        if (MODE == AT_FOX) { if (tid < 64) ((LAS float*)(vb + AT_VBYTES))[tid] = creg * LOG2E; }
        mcur = mreg;
    };
    f32x16 o[4];
#pragma unroll
    for (int i = 0; i < 4; ++i)
#pragma unroll
        for (int r = 0; r < 16; ++r) o[i][r] = 0.f;
    float mrun = -1e30f, lsum = 0.f;

    const int j0 = (MODE == AT_RET) ? q0 / 64 : 0;
    const int cst = q0 + 128 * (w >> 2);
    issue(j0); commit(j0 & 1);
    __syncthreads();
    for (int j = j0; j < nkt; ++j) {
        const unsigned long long mtile = mcur;
        if (j + 1 < nkt) issue(j + 1);
        if (64 * j <= qw0 + 31 && (MODE != AT_RET || 64 * j >= cst)) {
            LAS unsigned char* kb = lds + (j & 1) * AT_BUF; LAS unsigned char* vb = kb + AT_KBYTES;
            f32x16 s0, s1;
#pragma unroll
            for (int r = 0; r < 16; ++r) { s0[r] = 0.f; s1[r] = 0.f; }
            constexpr int KBATCH = 4;
            const LAS unsigned char* kp0 = kb + l31 * AT_KSTR + 16 * hf;
#pragma unroll
            for (int sb = 0; sb < 8; sb += KBATCH) {
                bf16x8 ka[KBATCH], kc[KBATCH];
#pragma unroll
                for (int s = 0; s < KBATCH; ++s) { ka[s] = *(const LAS bf16x8*)(kp0 + 32 * (sb + s)); kc[s] = *(const LAS bf16x8*)(kp0 + 32 * AT_KSTR + 32 * (sb + s)); }
                __builtin_amdgcn_sched_barrier(0);
#pragma unroll
                for (int s = 0; s < KBATCH; ++s) { s0 = MFMA32(ka[s], qf[sb + s], s0); s1 = MFMA32(kc[s], qf[sb + s], s1); }
                __builtin_amdgcn_sched_barrier(0);
            }
            const LAS unsigned char* vp0 = vb + l31 * AT_VSTR + 8 * hf;
            bf16x8 va[8];
            if (MODE != AT_DSA) {
#pragma unroll
            for (int dt = 0; dt < 2; ++dt)
#pragma unroll
                for (int ks = 0; ks < 4; ++ks) { const LAS unsigned char* vp = vp0 + 32 * dt * AT_VSTR + 32 * ks;
                    va[4 * dt + ks] = __builtin_shufflevector(*(const LAS s16x4*)vp, *(const LAS s16x4*)(vp + 16), 0, 1, 2, 3, 4, 5, 6, 7); }
            __builtin_amdgcn_sched_barrier(0); }
            const int kbase = 64 * j;
            const bool diag = (kbase + 63 > qw0);
            if (MODE == AT_RET) {
                const float rowf = xscale * __builtin_amdgcn_exp2f(lg * (float)(t - kbase - 63));
#pragma unroll
                for (int g = 0; g < 4; ++g) {
                    const f32x4 c0 = *(const LAS f32x4*)(tab + 8 * g + 4 * hf), c1 = *(const LAS f32x4*)(tab + 32 + 8 * g + 4 * hf);
#pragma unroll
                    for (int q = 0; q < 4; ++q) { const int r = 4 * g + q;
                        s0[r] = s0[r] * (rowf * c0[q]); s1[r] = s1[r] * (rowf * c1[q]); }
                }
                if (diag) {
#pragma unroll
                    for (int r = 0; r < 16; ++r) { const int key = kbase + crow(r, hf); if (key > t) s0[r] = 0.f; if (key + 32 > t) s1[r] = 0.f; } }
            } else {
                float mloc = -__builtin_inff();
                if (MODE == AT_FOX) {
                    const LAS float* ck = (const LAS float*)(vb + AT_VBYTES);
#pragma unroll
                    for (int g = 0; g < 4; ++g) {
                        const f32x4 c0 = *(const LAS f32x4*)(ck + 8 * g + 4 * hf), c1 = *(const LAS f32x4*)(ck + 32 + 8 * g + 4 * hf);
#pragma unroll
                        for (int q = 0; q < 4; ++q) { const int r = 4 * g + q; s0[r] = fmaf(s0[r], xscale, -c0[q]); s1[r] = fmaf(s1[r], xscale, -c1[q]); }
                    }
                    if (diag) {
#pragma unroll
                        for (int r = 0; r < 16; ++r) { const int key = kbase + crow(r, hf); if (key > t) s0[r] = -__builtin_inff(); if (key + 32 > t) s1[r] = -__builtin_inff(); } }
                    { float mb = mloc;
#pragma unroll
                      for (int r = 0; r < 16; r += 2) { asm("v_max3_f32 %0, %1, %2, %3" : "=v"(mloc) : "v"(mloc), "v"(s0[r]), "v"(s1[r])); asm("v_max3_f32 %0, %1, %2, %3" : "=v"(mb) : "v"(mb), "v"(s0[r + 1]), "v"(s1[r + 1])); }
                      asm("v_max_f32 %0, %1, %2" : "=v"(mloc) : "v"(mloc), "v"(mb)); }
                } else {
                    const unsigned long long mw = mtile; const int mlo = (int)(unsigned)mw, mhi = (int)(unsigned)(mw >> 32);
                    const float bconst = tab[512 + head]; const bool btab = (qw0 - (kbase + 63) < 113);
#pragma unroll
                    for (int r = 0; r < 16; ++r) { const int kk = crow(r, hf); const int key = kbase + kk;
                        float b0 = bconst, b1 = bconst;
                        if (btab) { int r0 = t - key; r0 = r0 < 0 ? 0 : (r0 > 127 ? 128 : r0); int r1 = t - key - 32; r1 = r1 < 0 ? 0 : (r1 > 127 ? 128 : r1);
                            b0 = r0 == 128 ? bconst : tab[head * 128 + r0]; b1 = r1 == 128 ? bconst : tab[head * 128 + r1]; }
                        const float x0 = fmaf(s0[r], xscale, b0), x1 = fmaf(s1[r], xscale, b1);
                        const int k0 = __builtin_amdgcn_sbfe(mlo, kk, 1), k1 = __builtin_amdgcn_sbfe(mhi, kk, 1);
                        s0[r] = __int_as_float((__float_as_int(x0) & k0) | (~k0 & (int)0xff800000)); s1[r] = __int_as_float((__float_as_int(x1) & k1) | (~k1 & (int)0xff800000));
                        asm("v_max3_f32 %0, %1, %2, %3" : "=v"(mloc) : "v"(mloc), "v"(s0[r]), "v"(s1[r])); }
                }
                mloc = fmaxf(mloc, __shfl_xor(mloc, 32));
                const float mnew = fmaxf(mrun, mloc);
                if (__any(mnew > mrun)) {
                    const float alpha = __builtin_amdgcn_exp2f(mrun - mnew); mrun = mnew;
                    lsum *= alpha;
#pragma unroll
                    for (int i = 0; i < 4; ++i)
#pragma unroll
                        for (int r = 0; r < 16; ++r) o[i][r] *= alpha;
                }
                float ps = 0.f;
#pragma unroll
                for (int r = 0; r < 16; ++r) { s0[r] = __builtin_amdgcn_exp2f(s0[r] - mnew); s1[r] = __builtin_amdgcn_exp2f(s1[r] - mnew); ps += s0[r] + s1[r]; }
                lsum += ps;
            }
            bf16x8 pf[2][2];
#pragma unroll
            for (int s2 = 0; s2 < 2; ++s2) {
                pf[0][s2] = pack8(s0[8 * s2], s0[8 * s2 + 1], s0[8 * s2 + 2], s0[8 * s2 + 3], s0[8 * s2 + 4], s0[8 * s2 + 5], s0[8 * s2 + 6], s0[8 * s2 + 7]);
                pf[1][s2] = pack8(s1[8 * s2], s1[8 * s2 + 1], s1[8 * s2 + 2], s1[8 * s2 + 3], s1[8 * s2 + 4], s1[8 * s2 + 5], s1[8 * s2 + 6], s1[8 * s2 + 7]);
            }
            if (MODE != AT_DSA) {
            bf16x8 vb2[8];
            __builtin_amdgcn_sched_barrier(0);
#pragma unroll
            for (int dt = 2; dt < 4; ++dt)
#pragma unroll
                for (int ks = 0; ks < 4; ++ks) { const LAS unsigned char* vp = vp0 + 32 * dt * AT_VSTR + 32 * ks;
                    vb2[4 * (dt - 2) + ks] = __builtin_shufflevector(*(const LAS s16x4*)vp, *(const LAS s16x4*)(vp + 16), 0, 1, 2, 3, 4, 5, 6, 7); }
            __builtin_amdgcn_sched_barrier(0);
#pragma unroll
            for (int dt = 0; dt < 2; ++dt)
#pragma unroll
                for (int ks = 0; ks < 4; ++ks) o[dt] = MFMA32(va[4 * dt + ks], pf[ks >> 1][ks & 1], o[dt]);
            __builtin_amdgcn_sched_barrier(0);
#pragma unroll
            for (int dt = 2; dt < 4; ++dt)
#pragma unroll
                for (int ks = 0; ks < 4; ++ks) o[dt] = MFMA32(vb2[4 * (dt - 2) + ks], pf[ks >> 1][ks & 1], o[dt]);
            } else {
#pragma unroll
            for (int dt = 0; dt < 4; ++dt) {
                bf16x8 vd[4];
#pragma unroll
                for (int ks = 0; ks < 4; ++ks) { const LAS unsigned char* vp = vp0 + 32 * dt * AT_VSTR + 32 * ks;
                    vd[ks] = __builtin_shufflevector(*(const LAS s16x4*)vp, *(const LAS s16x4*)(vp + 16), 0, 1, 2, 3, 4, 5, 6, 7); }
                __builtin_amdgcn_sched_barrier(0);
#pragma unroll
                for (int ks = 0; ks < 4; ++ks) o[dt] = MFMA32(vd[ks], pf[ks >> 1][ks & 1], o[dt]);
                __builtin_amdgcn_sched_barrier(0);
            } }
        }
        if (j + 1 < nkt) commit((j + 1) & 1);
        __syncthreads();
    }
    if (MODE == AT_RET) {
        const int nc0 = q0 / 128;
        const bf16_t* RT = (const bf16_t*)(c.ws + WS_KVT) + (size_t)((b * 4 + head) * 32 + nc0) * 32768;
#pragma unroll
        for (int p = 0; p < 8; ++p) { const int idx = tid + 512 * p, hsel = idx >> 11, rem = idx & 2047, row = rem >> 4, ch = rem & 15;
            *(LAS u32x4*)(lds + hsel * AT_BUF + row * AT_KSTR + ch * 16) = *(const u32x4*)(RT + (size_t)hsel * 32768 + row * 128 + ch * 8); }
        const float xi = exp2f(lg * (float)(((qw0 + l31) & 127) + 1));
#pragma unroll
        for (int s = 0; s < 8; ++s) { const u32x4 wv = __builtin_bit_cast(u32x4, qf[s]);
            qf[s] = pack8(lo_bf(wv.x) * xi, hi_bf(wv.x) * xi, lo_bf(wv.y) * xi, hi_bf(wv.y) * xi, lo_bf(wv.z) * xi, hi_bf(wv.z) * xi, lo_bf(wv.w) * xi, hi_bf(wv.w) * xi); }
        __syncthreads();
        const LAS unsigned char* rp0 = lds + (w >> 2) * AT_BUF + l31 * AT_KSTR + 16 * hf;
#pragma unroll
        for (int dt = 0; dt < 4; ++dt) {
            bf16x8 ra[8];
#pragma unroll
            for (int s = 0; s < 8; ++s) ra[s] = *(const LAS bf16x8*)(rp0 + 32 * dt * AT_KSTR + 32 * s);
            __builtin_amdgcn_sched_barrier(0);
#pragma unroll
            for (int s = 0; s < 8; ++s) o[dt] = MFMA32(ra[s], qf[s], o[dt]);
            __builtin_amdgcn_sched_barrier(0);
        }
    }
    bf16_t* Op = WSP(bf16_t, WS_BR) + (size_t)(b * SEQ + t) * D + ocol;
    if (MODE == AT_RET) {
        float s = 0.f;
#pragma unroll
        for (int i = 0; i < 4; ++i)
#pragma unroll
            for (int r = 0; r < 16; ++r) s += o[i][r];
        s += __shfl_xor(s, 32);
        const float mu = s * (1.f / 128.f); float v = 0.f;
#pragma unroll
        for (int i = 0; i < 4; ++i)
#pragma unroll
            for (int r = 0; r < 16; ++r) { const float d = o[i][r] - mu; v += d * d; }
        v += __shfl_xor(v, 32);
        const float rs = rsqrtf(v * (1.f / 128.f) + EPS);
        const bf16_t* gp = P + (size_t)(b * SEQ + t) * NP + C_RG + head * 128;
#pragma unroll
        for (int i = 0; i < 4; ++i)
#pragma unroll
            for (int g = 0; g < 4; ++g) { const int d0 = 32 * i + 8 * g + 4 * hf;
                const u32x2 gw = *(const u32x2*)(gp + d0);
                u32x2 wv; wv.x = pk2((o[i][4 * g] - mu) * rs * siluf_(lo_bf(gw.x)), (o[i][4 * g + 1] - mu) * rs * siluf_(hi_bf(gw.x)));
                wv.y = pk2((o[i][4 * g + 2] - mu) * rs * siluf_(lo_bf(gw.y)), (o[i][4 * g + 3] - mu) * rs * siluf_(hi_bf(gw.y)));
                *(u32x2*)(Op + d0) = wv; }
    } else {
        const float lt = lsum + __shfl_xor(lsum, 32), inv = 1.f / lt;
#pragma unroll
        for (int i = 0; i < 4; ++i)
#pragma unroll
            for (int g = 0; g < 4; ++g) { const int d0 = 32 * i + 8 * g + 4 * hf;
                u32x2 wv; wv.x = pk2(o[i][4 * g] * inv, o[i][4 * g + 1] * inv); wv.y = pk2(o[i][4 * g + 2] * inv, o[i][4 * g + 3] * inv);
                *(u32x2*)(Op + d0) = wv; }
    }
}

constexpr int IX_QSTR = 2064;
DI void idx_unit(const Ctx& c, int b, int q0) {
    LAS unsigned char* lds = c.lds;
    const int tid = c.tid, w = c.wave, lane = c.lane, l31 = lane & 31, hf = lane >> 5;
    const bf16_t* QD = WSP(bf16_t, WS_QD); const bf16_t* P = WSP(bf16_t, WS_PROJ); float* SC = WSP(float, WS_SC);
    const int t = q0 + l31;
    __syncthreads();
#pragma unroll
    for (int p = 0; p < 8; ++p) { const int idx = tid + 512 * p, r = idx >> 7, ch = idx & 127;
        *(LAS u32x4*)(lds + r * IX_QSTR + ch * 16) = *(const u32x4*)(QD + (size_t)(b * SEQ + q0 + r) * 1536 + 512 + ch * 8); }
    LAS float* wtab = (LAS float*)(lds + 32 * IX_QSTR);
    { const int r = tid >> 4, hh = tid & 15; wtab[hh * 32 + r] = bf2f(P[(size_t)(b * SEQ + q0 + r) * NP + C_IW + hh]) * 0.03125f; }
    __syncthreads();
    const int nkt = (q0 + 32 + 63) / 64;
    bf16x8 kn[2][4];
    { const int j0 = w < nkt ? w : 0;
#pragma unroll
      for (int k2 = 0; k2 < 2; ++k2) { const bf16_t* kp = P + (size_t)(b * SEQ + 64 * j0 + 32 * k2 + l31) * NP + C_IK + 8 * hf;
#pragma unroll
          for (int s = 0; s < 4; ++s) kn[k2][s] = *(const bf16x8*)(kp + 16 * s); } }
    for (int jt = w; jt < nkt; jt += 8) {
        bf16x8 kf[2][4];
#pragma unroll
        for (int k2 = 0; k2 < 2; ++k2)
#pragma unroll
            for (int s = 0; s < 4; ++s) kf[k2][s] = kn[k2][s];
        { const int jn = jt + 8 < nkt ? jt + 8 : jt;
#pragma unroll
          for (int k2 = 0; k2 < 2; ++k2) { const bf16_t* kp = P + (size_t)(b * SEQ + 64 * jn + 32 * k2 + l31) * NP + C_IK + 8 * hf;
#pragma unroll
              for (int s = 0; s < 4; ++s) kn[k2][s] = *(const bf16x8*)(kp + 16 * s); } }
        f32x16 a0, a1;
#pragma unroll
        for (int r = 0; r < 16; ++r) { a0[r] = 0.f; a1[r] = 0.f; }
#pragma unroll 1
        for (int h = 0; h < 16; ++h) {
            f32x16 c0, c1;
#pragma unroll
            for (int r = 0; r < 16; ++r) { c0[r] = 0.f; c1[r] = 0.f; }
            const float wh = wtab[h * 32 + l31];
            const LAS unsigned char* qp = lds + l31 * IX_QSTR + h * 128 + 16 * hf;
#pragma unroll
            for (int s = 0; s < 4; ++s) { const bf16x8 bq = *(const LAS bf16x8*)(qp + 32 * s);
                c0 = MFMA32(kf[0][s], bq, c0); c1 = MFMA32(kf[1][s], bq, c1); }
#pragma unroll
            for (int r = 0; r < 16; ++r) {
                const int i0 = __float_as_int(c0[r]), i1 = __float_as_int(c1[r]);
                a0[r] += wh * __int_as_float(i0 > 0 ? i0 : 0); a1[r] += wh * __int_as_float(i1 > 0 ? i1 : 0); }
        }
        float* dst = SC + (size_t)(b * SEQ + t) * SC_LD + 64 * jt + 4 * hf;
#pragma unroll
        for (int g = 0; g < 4; ++g) { *(f32x4*)(dst + 8 * g) = (f32x4){a0[4 * g], a0[4 * g + 1], a0[4 * g + 2], a0[4 * g + 3]};
            *(f32x4*)(dst + 32 + 8 * g) = (f32x4){a1[4 * g], a1[4 * g + 1], a1[4 * g + 2], a1[4 * g + 3]}; }
    }
}
constexpr int SEL_WORDS = 2048 + 256 + 64;
DI int sel_bin(float v, float scale, float off) { return (int)__builtin_amdgcn_fmed3f(fmaf(v, scale, off), 0.f, 2047.f); }
DI void select_rows(const Ctx& c) {
    const int gw = c.bid * 8 + c.wave, NGW = c.G * 8;
    const float* SC = WSP(float, WS_SC); unsigned long long* MK = WSP(unsigned long long, WS_MASK);
    LAS unsigned* hist = (LAS unsigned*)(c.lds) + c.wave * SEL_WORDS;
    LAS float* list = (LAS float*)(hist + 2048);
    const float NINF = -__builtin_inff(), PINF = __builtin_inff();
    for (int m = gw; m < M; m += NGW) {
        int lane = c.lane; asm volatile("" : "+v"(lane));
        const int t = m & (SEQ - 1), jmax = t >> 6;
        const float* row = SC + (size_t)m * SC_LD;
        float val[64];
#pragma unroll
        for (int j = 0; j < 64; ++j) val[j] = NINF;
#pragma unroll
        for (int j8 = 0; j8 < 8; ++j8) {
            if (8 * j8 + 7 < jmax) {
#pragma unroll
                for (int j = 8 * j8; j < 8 * j8 + 8; ++j) val[j] = row[64 * j + lane]; }
            else if (8 * j8 <= jmax) {
#pragma unroll
                for (int j = 8 * j8; j < 8 * j8 + 8; ++j) { const int s = 64 * j + lane; const float v = row[s <= t ? s : t]; val[j] = s <= t ? v : NINF; } } }
        float thr = NINF;
        if (t >= 256) {
            float lo = PINF, hi = NINF;
#pragma unroll
            for (int j8 = 0; j8 < 8; ++j8) {
                if (8 * j8 + 7 < jmax) {
#pragma unroll
                    for (int j = 8 * j8; j < 8 * j8 + 8; ++j) { hi = fmaxf(hi, val[j]); lo = fminf(lo, val[j]); } }
                else if (8 * j8 <= jmax) {
#pragma unroll
                    for (int j = 8 * j8; j < 8 * j8 + 8; ++j) { hi = fmaxf(hi, val[j]); lo = fminf(lo, val[j] == NINF ? PINF : val[j]); } } }
#pragma unroll
            for (int o = 1; o < 64; o <<= 1) { hi = fmaxf(hi, __shfl_xor(hi, o)); lo = fminf(lo, __shfl_xor(lo, o)); }
            const float scale = (hi > lo) ? 2046.f / (hi - lo) : 0.f, off = 1.f - lo * scale;
            asm volatile("s_waitcnt lgkmcnt(0)" ::: "memory");
#pragma unroll
            for (int q = 0; q < 8; ++q) *(LAS u32x4*)(hist + 32 * lane + 4 * q) = (u32x4){0u, 0u, 0u, 0u};
            asm volatile("s_waitcnt lgkmcnt(0)" ::: "memory");
#pragma unroll
            for (int j8 = 0; j8 < 8; ++j8) if (8 * j8 <= jmax) {
#pragma unroll
                for (int j = 8 * j8; j < 8 * j8 + 8; ++j) __hip_atomic_fetch_add(hist + sel_bin(val[j], scale, off), 1u, __ATOMIC_RELAXED, __HIP_MEMORY_SCOPE_WORKGROUP); }
            asm volatile("s_waitcnt lgkmcnt(0)" ::: "memory");
            int T = 0;
#pragma unroll
            for (int q = 0; q < 8; ++q) { const u32x4 v = *(const LAS u32x4*)(hist + 32 * lane + 4 * q); T += (int)(v.x + v.y + v.z + v.w); }
            if (lane == 0) T -= (int)hist[0];
            int S = T;
#pragma unroll
            for (int o = 1; o < 64; o <<= 1) { const int v = __shfl_down(S, o); if (lane + o < 64) S += v; }
            const unsigned long long bm = __ballot(S >= 256);
            const int L = 63 - __builtin_clzll(bm | 1ull);
            const int need2 = 256 - (S - T);
            int run = 0, bsel = 0, above = 0, inb = 0; bool found = false;
#pragma unroll
            for (int q = 7; q >= 0; --q) { const u32x4 v = *(const LAS u32x4*)(hist + 32 * lane + 4 * q);
#pragma unroll
                for (int e = 3; e >= 0; --e) { const int h = (int)v[e]; run += h; if (!found && run >= need2) { found = true; bsel = 4 * q + e; above = run - h; inb = h; } } }
            const int B0 = 32 * L + __builtin_amdgcn_readlane(bsel, L);
            const int need = __builtin_amdgcn_readlane(need2, L) - __builtin_amdgcn_readlane(above, L);
            const int cnt = __builtin_amdgcn_readlane(inb, L);
            if (cnt <= 256 && B0 > 0) {
                int pos = 0;
#pragma unroll
                for (int j8 = 0; j8 < 8; ++j8) if (8 * j8 <= jmax) {
#pragma unroll
                  for (int j = 8 * j8; j < 8 * j8 + 8; ++j) { const float v = val[j];
                    const bool in = sel_bin(v, scale, off) == B0;
                    const unsigned long long mm = __ballot(in);
                    if (mm != 0ull) { const int p = pos + (int)__builtin_amdgcn_mbcnt_hi((unsigned)(mm >> 32), __builtin_amdgcn_mbcnt_lo((unsigned)mm, 0u)); if (in) list[p] = v; pos += __builtin_popcountll(mm); }
                    if ((j & 3) == 3) __builtin_amdgcn_sched_barrier(0); } }
                asm volatile("s_waitcnt lgkmcnt(0)" ::: "memory");
                float best = NINF;
                for (int i0 = 0; i0 < cnt; i0 += 64) { const int i = i0 + lane; const float mine = i < cnt ? list[i] : PINF; int rk = 0;
                    for (int k = 0; k < cnt; ++k) rk += (list[k] >= mine) ? 1 : 0;
                    if (i < cnt && rk >= need) best = fmaxf(best, mine); }
#pragma unroll
                for (int o = 1; o < 64; o <<= 1) best = fmaxf(best, __shfl_xor(best, o));
                thr = best;
            } else {
                unsigned prefix = 0u;
                for (int bit = 31; bit >= 0; --bit) { const unsigned cand = prefix | (1u << bit); int cn = 0;
#pragma unroll
                    for (int j = 0; j < 64; ++j) { const unsigned u = __float_as_uint(val[j]); const unsigned k = val[j] == NINF ? 0u : ((u & 0x80000000u) ? ~u : (u | 0x80000000u)); cn += (k >= cand) ? 1 : 0; }
#pragma unroll
                    for (int o = 1; o < 64; o <<= 1) cn += __shfl_xor(cn, o);
                    if (cn >= 256) prefix = cand; }
                thr = __uint_as_float((prefix & 0x80000000u) ? (prefix & 0x7fffffffu) : ~prefix);
            }
        }
        int mlo = 0, mhi = 0;
#pragma unroll
        for (int j8 = 0; j8 < 8; ++j8) if (8 * j8 <= jmax) {
#pragma unroll
          for (int j = 8 * j8; j < 8 * j8 + 8; ++j) { const unsigned long long bm = __ballot(val[j] >= thr);
            asm volatile("s_nop 4\n\tv_writelane_b32 %0, %2, %4\n\tv_writelane_b32 %1, %3, %4" : "+v"(mlo), "+v"(mhi) : "s"((unsigned)bm), "s"((unsigned)(bm >> 32)), "n"(j)); } }
        unsigned long long mine = ((unsigned long long)(unsigned)mhi << 32) | (unsigned)mlo;
        if (t < 256) mine = (64 * lane + 63 <= t) ? ~0ull : (64 * lane > t ? 0ull : ((2ull << (t - 64 * lane)) - 1ull));
        MK[(size_t)m * 64 + lane] = mine;
    }
}
constexpr int GP_KN = 0;
constexpr int GP_VV = 33024;
constexpr int GP_KB = 65792;
constexpr int GP_QB = 83200;
constexpr int GP_L = 100608;
constexpr int GP_BETA = 118016, GP_G = 118272, GP_EG = 118528;
DI void gdn_prep(const Ctx& c, int l, int unit) {
    LAS unsigned char* lds = c.lds;
    const int tid = c.tid, w = c.wave, lane = c.lane, l31 = lane & 31, hf = lane >> 5;
    const int n = unit & 63, h = (unit >> 6) & 3, b = unit >> 8;
    const int row0 = b * SEQ + n * 64;
    const bf16_t* P = WSP(bf16_t, WS_PROJ);
    LAS float* kn = (LAS float*)(lds + GP_KN); LAS float* vv = (LAS float*)(lds + GP_VV);
    LAS bf16_t* kb = (LAS bf16_t*)(lds + GP_KB); LAS bf16_t* qb = (LAS bf16_t*)(lds + GP_QB);
    LAS float* Lm = (LAS float*)(lds + GP_L); LAS float* beta = (LAS float*)(lds + GP_BETA); LAS float* gg = (LAS float*)(lds + GP_G); LAS float* eg = (LAS float*)(lds + GP_EG);
    __syncthreads();
    if (w == 0) {
        const float bl = bf2f(P[(size_t)(row0 + lane) * NP + C_GB + h]), al = bf2f(P[(size_t)(row0 + lane) * NP + C_GA + h]);
        const float A = __expf(INP(IN_GDN_ALOG)[l * 4 + h]); const float xx = al + INP(IN_GDN_DT)[l * 4 + h];
        const float sp = xx > 20.f ? xx : __logf(1.f + __expf(xx));
        float g = -A * sp;
#pragma unroll
        for (int o = 1; o < 64; o <<= 1) { const float tt = __shfl_up(g, o); if (lane >= o) g += tt; }
        beta[lane] = sigmoidf_(bl); gg[lane] = g; eg[lane] = __expf(g);
    }
    {
        const int tok = tid >> 3, part = tid & 7, pos = n * 64 + tok;
        const float* cwl = INP(IN_GDN_CONV) + (size_t)l * 4 * 1536;
#pragma unroll
        for (int which = 0; which < 3; ++which) {
            const int ccol = which * 512 + h * 128 + 16 * part;
            float y[16];
#pragma unroll
            for (int e = 0; e < 16; ++e) y[e] = 0.f;
#pragma unroll
            for (int i = 0; i < 4; ++i) {
                {
                    const int dlt = (pos - 3 + i >= 0) ? (i - 3) : 0;
                    const float live = (pos - 3 + i >= 0) ? 1.f : 0.f;
                    const bf16_t* src = P + (size_t)(row0 + tok + dlt) * NP + C_GQ + ccol;
                    const u32x4 x0 = *(const u32x4*)src, x1 = *(const u32x4*)(src + 8);
                    const float* wp = cwl + i * 1536 + ccol;
                    const f32x4 w0 = *(const f32x4*)wp * live, w1 = *(const f32x4*)(wp + 4) * live, w2 = *(const f32x4*)(wp + 8) * live, w3 = *(const f32x4*)(wp + 12) * live;
                    y[0] += w0.x * lo_bf(x0.x); y[1] += w0.y * hi_bf(x0.x); y[2] += w0.z * lo_bf(x0.y); y[3] += w0.w * hi_bf(x0.y);
                    y[4] += w1.x * lo_bf(x0.z); y[5] += w1.y * hi_bf(x0.z); y[6] += w1.z * lo_bf(x0.w); y[7] += w1.w * hi_bf(x0.w);
                    y[8] += w2.x * lo_bf(x1.x); y[9] += w2.y * hi_bf(x1.x); y[10] += w2.z * lo_bf(x1.y); y[11] += w2.w * hi_bf(x1.y);
                    y[12] += w3.x * lo_bf(x1.z); y[13] += w3.y * hi_bf(x1.z); y[14] += w3.z * lo_bf(x1.w); y[15] += w3.w * hi_bf(x1.w);
                }
            }
            float ss = 0.f;
#pragma unroll
            for (int e = 0; e < 16; ++e) { y[e] = siluf_(y[e]); ss += y[e] * y[e]; }
            if (which < 2) {
                ss += __shfl_xor(ss, 1); ss += __shfl_xor(ss, 2); ss += __shfl_xor(ss, 4);
                const float r = rsqrtf(ss + EPS) * (which == 0 ? SM_SCALE : 1.f);
#pragma unroll
                for (int e = 0; e < 16; ++e) y[e] *= r;
                LAS bf16_t* dstb = (which == 0 ? qb : kb) + tok * 136 + 16 * part;
#pragma unroll
                for (int e = 0; e < 16; e += 2) *(LAS unsigned*)(dstb + e) = pk2(y[e], y[e + 1]);
                if (which == 1) {
#pragma unroll
                    for (int e = 0; e < 16; ++e) kn[tok * 129 + 16 * part + e] = y[e]; }
            } else {
#pragma unroll
                for (int e = 0; e < 16; ++e) vv[tok * 128 + 16 * part + e] = y[e];
            }
        }
    }
    __syncthreads();
    {
        const int which = w >> 2, ti = (w >> 1) & 1, tj = w & 1;
        const LAS bf16_t* Ab = (which ? qb : kb) + (32 * ti + l31) * 136 + 8 * hf;
        const LAS bf16_t* Bb = kb + (32 * tj + l31) * 136 + 8 * hf;
        f32x16 acc;
#pragma unroll
        for (int r = 0; r < 16; ++r) acc[r] = 0.f;
#pragma unroll
        for (int s = 0; s < 8; ++s) acc = MFMA32(*(const LAS bf16x8*)(Ab + 16 * s), *(const LAS bf16x8*)(Bb + 16 * s), acc);
        const int sc = 32 * tj + l31; const float gs = gg[sc];
        bf16_t* QKM = WSP(bf16_t, WS_QKM) + (size_t)unit * 4096;
#pragma unroll
        for (int r = 0; r < 16; ++r) { const int cc = 32 * ti + crow(r, hf);
            const float dec = __expf(fminf(gg[cc] - gs, 0.f));
            if (which == 0) Lm[sc * 68 + cc] = (cc > sc) ? beta[cc] * acc[r] * dec : 0.f;
            else QKM[cc * 64 + sc] = f2bf((cc >= sc) ? acc[r] * dec : 0.f); }
    }
    __syncthreads();
    if (tid < 256) {
        float x[64];
        if (tid < 128) {
#pragma unroll
            for (int i = 0; i < 64; ++i) x[i] = vv[i * 128 + tid] * beta[i]; }
        else {
#pragma unroll
            for (int i = 0; i < 64; ++i) x[i] = kn[i * 129 + tid - 128] * (beta[i] * eg[i]); }
        int zv = 0; asm volatile("" : "+v"(zv));
        const LAS float* Lz = Lm + zv;
        f32x4 colv[2][16];
#pragma unroll
        for (int g = 0; g < 16; ++g) colv[0][g] = *(const LAS f32x4*)(Lz + 4 * g);
#pragma unroll
        for (int j = 0; j < 63; ++j) { const float xj = x[j];
            if (j + 1 < 63) {
#pragma unroll
                for (int g = (j + 2) >> 2; g < 16; ++g) colv[(j + 1) & 1][g] = *(const LAS f32x4*)(Lz + (j + 1) * 68 + 4 * g); }
            __builtin_amdgcn_sched_barrier(0);
#pragma unroll
            for (int g = (j + 1) >> 2; g < 16; ++g) { const f32x4 lv = colv[j & 1][g];
                x[4 * g] -= lv.x * xj; x[4 * g + 1] -= lv.y * xj; x[4 * g + 2] -= lv.z * xj; x[4 * g + 3] -= lv.w * xj; }
            __builtin_amdgcn_sched_barrier(0); }
        if (tid < 128) { float* U0 = WSP(float, WS_U0) + (size_t)row0 * 512 + h * 128 + tid;
#pragma unroll
            for (int i = 0; i < 64; ++i) U0[(size_t)i * 512] = x[i]; }
        else { bf16_t* KC = WSP(bf16_t, WS_KCUM) + (size_t)row0 * 512 + h * 128 + tid - 128;
#pragma unroll
            for (int i = 0; i < 64; ++i) KC[(size_t)i * 512] = f2bf(x[i]); }
    } else {
        const int t2 = tid - 256; const float gl = gg[63];
        bf16_t* QDEC = WSP(bf16_t, WS_QDEC) + (size_t)row0 * 512 + h * 128;
#pragma unroll 4
        for (int k = 0; k < 32; ++k) { const int e = t2 + 256 * k, cc = e >> 7, d = e & 127; QDEC[(size_t)cc * 512 + d] = f2bf(bf2f(qb[cc * 136 + d]) * eg[cc]); }
        bf16_t* KDT = WSP(bf16_t, WS_KDT) + (size_t)unit * 8192;
#pragma unroll 4
        for (int k = 0; k < 32; ++k) { const int e = t2 + 256 * k, d = e >> 6, cc = e & 63; KDT[d * 64 + cc] = f2bf(kn[cc * 129 + d] * __expf(gl - gg[cc])); }
        if (t2 == 0) WSP(float, WS_EGL)[unit] = __expf(gl);
    }
}

constexpr int GS_KC = 0, GS_QD = 16896, GS_QK = 33792, GS_KD = 42496, GS_BUF = 59904;
DI void gdn_scan(const Ctx& c, int item) {
    LAS unsigned char* lds = c.lds;
    const int tid = c.tid, w = c.wave, lane = c.lane, l31 = lane & 31, hf = lane >> 5;
    const int b = item >> 2, h = item & 3;
    const bf16_t* KC = WSP(bf16_t, WS_KCUM) + (size_t)(b * SEQ) * 512 + h * 128;
    const bf16_t* QDc = WSP(bf16_t, WS_QDEC) + (size_t)(b * SEQ) * 512 + h * 128;
    const bf16_t* QKM = WSP(bf16_t, WS_QKM) + (size_t)(b * 4 + h) * 64 * 4096;
    const bf16_t* KDT = WSP(bf16_t, WS_KDT) + (size_t)(b * 4 + h) * 64 * 8192;
    const float* U0 = WSP(float, WS_U0) + (size_t)(b * SEQ) * 512 + h * 128;
    const float* EGL = WSP(float, WS_EGL) + (b * 4 + h) * 64;
    float* OG = WSP(float, WS_OG) + (size_t)(b * SEQ) * 512 + h * 128;
    u32x4 stA[14], stB[14];
#define GS_ISSUE(n_, st) do { const int t2 = tid - 256; \
        _Pragma("unroll") for (int k = 0; k < 4; ++k) { const int idx = t2 + 256 * k, cc = idx >> 4, ch = idx & 15; \
            st[k] = *(const u32x4*)(KC + (size_t)((n_) * 64 + cc) * 512 + ch * 8); st[4 + k] = *(const u32x4*)(QDc + (size_t)((n_) * 64 + cc) * 512 + ch * 8); } \
        _Pragma("unroll") for (int k = 0; k < 2; ++k) { const int idx = t2 + 256 * k; st[8 + k] = *(const u32x4*)(QKM + (size_t)(n_) * 4096 + idx * 8); } \
        _Pragma("unroll") for (int k = 0; k < 4; ++k) { const int idx = t2 + 256 * k; st[10 + k] = *(const u32x4*)(KDT + (size_t)(n_) * 8192 + idx * 8); } } while (0)
#define GS_COMMIT(buf_, st) do { const int t2 = tid - 256; LAS unsigned char* bb = lds + (buf_) * GS_BUF; \
        _Pragma("unroll") for (int k = 0; k < 4; ++k) { const int idx = t2 + 256 * k, cc = idx >> 4, ch = idx & 15; \
            LAS u32x2* d0 = (LAS u32x2*)(bb + GS_KC + cc * 264 + ch * 16); d0[0] = (u32x2){st[k].x, st[k].y}; d0[1] = (u32x2){st[k].z, st[k].w}; \
            LAS u32x2* d1 = (LAS u32x2*)(bb + GS_QD + cc * 264 + ch * 16); d1[0] = (u32x2){st[4 + k].x, st[4 + k].y}; d1[1] = (u32x2){st[4 + k].z, st[4 + k].w}; } \
        _Pragma("unroll") for (int k = 0; k < 2; ++k) { const int idx = t2 + 256 * k, cc = idx >> 3, ch = idx & 7; \
            LAS u32x2* d0 = (LAS u32x2*)(bb + GS_QK + cc * 136 + ch * 16); d0[0] = (u32x2){st[8 + k].x, st[8 + k].y}; d0[1] = (u32x2){st[8 + k].z, st[8 + k].w}; } \
        _Pragma("unroll") for (int k = 0; k < 4; ++k) { const int idx = t2 + 256 * k, dd = idx >> 3, ch = idx & 7; \
            LAS u32x2* d0 = (LAS u32x2*)(bb + GS_KD + dd * 136 + ch * 16); d0[0] = (u32x2){st[10 + k].x, st[10 + k].y}; d0[1] = (u32x2){st[10 + k].z, st[10 + k].w}; } } while (0)
    __syncthreads();
    if (w >= 4) { GS_ISSUE(0, stA); GS_COMMIT(0, stA); }
    __syncthreads();
    if (w >= 4) {
        GS_ISSUE(1, stA);
        for (int n = 0; n < 64; n += 2) {
            if (n + 2 < 64) GS_ISSUE(n + 2, stB);
            if (n + 1 < 64) GS_COMMIT((n + 1) & 1, stA);
            __syncthreads();
            if (n + 3 < 64) GS_ISSUE(n + 3, stA);
            if (n + 2 < 64) GS_COMMIT(n & 1, stB);
            __syncthreads();
        }
    } else {
    f32x16 S[4];
#pragma unroll
    for (int i = 0; i < 4; ++i)
#pragma unroll
        for (int r = 0; r < 16; ++r) S[i][r] = 0.f;
    f32x16 u[2]; float egl_n = 0.f;
    if (w < 4) { const int e0 = 32 * w + l31;
#pragma unroll
        for (int ct = 0; ct < 2; ++ct)
#pragma unroll
            for (int r = 0; r < 16; ++r) u[ct][r] = U0[(size_t)(32 * ct + crow(r, hf)) * 512 + e0];
        egl_n = EGL[0]; }
    for (int n = 0; n < 64; ++n) {
        {
            const LAS unsigned char* bb = lds + (n & 1) * GS_BUF;
            const int e0 = 32 * w + l31;
            const float egl = egl_n;
            bf16x8 Sb[8];
#pragma unroll
            for (int dt = 0; dt < 4; ++dt)
#pragma unroll
                for (int s2 = 0; s2 < 2; ++s2) Sb[2 * dt + s2] = pack8(S[dt][8 * s2], S[dt][8 * s2 + 1], S[dt][8 * s2 + 2], S[dt][8 * s2 + 3], S[dt][8 * s2 + 4], S[dt][8 * s2 + 5], S[dt][8 * s2 + 6], S[dt][8 * s2 + 7]);
#define GS_FRAG(p) __builtin_shufflevector(*(const LAS s16x4*)(p), *(const LAS s16x4*)((p) + 16), 0, 1, 2, 3, 4, 5, 6, 7)
            f32x16 a1[2];
#pragma unroll
            for (int ct = 0; ct < 2; ++ct) {
#pragma unroll
                for (int r = 0; r < 16; ++r) a1[ct][r] = 0.f;
                bf16x8 fr[8];
#pragma unroll
                for (int ks = 0; ks < 8; ++ks) fr[ks] = GS_FRAG(bb + GS_KC + (32 * ct + l31) * 264 + (16 * ks + 4 * hf) * 2);
                __builtin_amdgcn_sched_barrier(0);
#pragma unroll
                for (int ks = 0; ks < 8; ++ks) a1[ct] = MFMA32(fr[ks], Sb[ks], a1[ct]);
                __builtin_amdgcn_sched_barrier(0);
            }
            bf16x8 vb[4];
#pragma unroll
            for (int ct = 0; ct < 2; ++ct) {
#pragma unroll
                for (int r = 0; r < 16; ++r) u[ct][r] -= a1[ct][r];
#pragma unroll
                for (int s2 = 0; s2 < 2; ++s2) vb[2 * ct + s2] = pack8(u[ct][8 * s2], u[ct][8 * s2 + 1], u[ct][8 * s2 + 2], u[ct][8 * s2 + 3], u[ct][8 * s2 + 4], u[ct][8 * s2 + 5], u[ct][8 * s2 + 6], u[ct][8 * s2 + 7]);
            }
            f32x16 oo[2];
#pragma unroll
            for (int ct = 0; ct < 2; ++ct) {
#pragma unroll
                for (int r = 0; r < 16; ++r) oo[ct][r] = 0.f;
                bf16x8 fr[8];
#pragma unroll
                for (int ks = 0; ks < 8; ++ks) fr[ks] = GS_FRAG(bb + GS_QD + (32 * ct + l31) * 264 + (16 * ks + 4 * hf) * 2);
                __builtin_amdgcn_sched_barrier(0);
#pragma unroll
                for (int ks = 0; ks < 8; ++ks) oo[ct] = MFMA32(fr[ks], Sb[ks], oo[ct]);
                __builtin_amdgcn_sched_barrier(0);
            }
            { bf16x8 fr[8];
#pragma unroll
              for (int ct = 0; ct < 2; ++ct)
#pragma unroll
                  for (int ks = 0; ks < 4; ++ks) fr[4 * ct + ks] = GS_FRAG(bb + GS_QK + (32 * ct + l31) * 136 + (16 * ks + 4 * hf) * 2);
              __builtin_amdgcn_sched_barrier(0);
#pragma unroll
              for (int ct = 0; ct < 2; ++ct)
#pragma unroll
                  for (int ks = 0; ks < 4; ++ks) oo[ct] = MFMA32(fr[4 * ct + ks], vb[ks], oo[ct]);
              __builtin_amdgcn_sched_barrier(0); }
#pragma unroll
            for (int ct = 0; ct < 2; ++ct)
#pragma unroll
                for (int r = 0; r < 16; ++r) OG[(size_t)(n * 64 + 32 * ct + crow(r, hf)) * 512 + e0] = oo[ct][r];
            { const int nn = n + 1 < 64 ? n + 1 : n;
#pragma unroll
              for (int ct = 0; ct < 2; ++ct)
#pragma unroll
                  for (int r = 0; r < 16; ++r) u[ct][r] = U0[(size_t)(nn * 64 + 32 * ct + crow(r, hf)) * 512 + e0];
              egl_n = EGL[nn]; }
#pragma unroll
            for (int dh = 0; dh < 2; ++dh) {
                bf16x8 fr[8];
#pragma unroll
                for (int d2 = 0; d2 < 2; ++d2)
#pragma unroll
                    for (int ks = 0; ks < 4; ++ks) fr[4 * d2 + ks] = GS_FRAG(bb + GS_KD + (32 * (2 * dh + d2) + l31) * 136 + (16 * ks + 4 * hf) * 2);
#pragma unroll
                for (int d2 = 0; d2 < 2; ++d2)
#pragma unroll
                    for (int r = 0; r < 16; ++r) S[2 * dh + d2][r] *= egl;
                __builtin_amdgcn_sched_barrier(0);
#pragma unroll
                for (int d2 = 0; d2 < 2; ++d2)
#pragma unroll
                    for (int ks = 0; ks < 4; ++ks) S[2 * dh + d2] = MFMA32(fr[4 * d2 + ks], vb[ks], S[2 * dh + d2]);
                __builtin_amdgcn_sched_barrier(0);
            }
#undef GS_FRAG
        }
        __syncthreads();
    }
    }
}

DI void ret_chunk_kv(const Ctx& c, int unit) {
    LAS unsigned char* lds = c.lds;
    const int tid = c.tid, w = c.wave, lane = c.lane, l31 = lane & 31, hf = lane >> 5;
    const int n = unit & 31, h = (unit >> 5) & 3, b = unit >> 7;
    const int row0 = b * SEQ + 128 * n;
    const bf16_t* P = WSP(bf16_t, WS_PROJ);
    const float* cs = WSP(float, WS_ROPE); const float* sn = cs + SEQ * 64;
    LAS bf16_t* Vt = (LAS bf16_t*)lds; LAS bf16_t* Kt = (LAS bf16_t*)(lds + 128 * 272);
    const float lg = log2f(1.f - exp2f(-5.f - (float)h));
    __syncthreads();
#pragma unroll
    for (int p = 0; p < 4; ++p) { const int idx = tid + 512 * p, cc = idx >> 4, e8 = (idx & 15) * 8;
        const u32x4 vv = *(const u32x4*)(P + (size_t)(row0 + cc) * NP + C_RV + h * 128 + e8);
#pragma unroll
        for (int q = 0; q < 4; ++q) { Vt[(e8 + 2 * q) * 136 + cc] = (bf16_t)(vv[q] & 0xffffu); Vt[(e8 + 2 * q + 1) * 136 + cc] = (bf16_t)(vv[q] >> 16); } }
#pragma unroll
    for (int p = 0; p < 2; ++p) { const int idx = tid + 512 * p, cc = idx >> 3, i8 = (idx & 7) * 8;
        const bf16_t* kp = P + (size_t)(row0 + cc) * NP + C_RK + h * 128 + i8;
        const u32x4 k1 = *(const u32x4*)kp, k2 = *(const u32x4*)(kp + 64);
        const int pos = 128 * n + cc; const float zs = SM_SCALE * exp2f(lg * (float)(127 - cc));
        const f32x4 c0 = *(const f32x4*)(cs + pos * 64 + i8), c1 = *(const f32x4*)(cs + pos * 64 + i8 + 4), s0 = *(const f32x4*)(sn + pos * 64 + i8), s1 = *(const f32x4*)(sn + pos * 64 + i8 + 4);
#pragma unroll
        for (int q = 0; q < 4; ++q) {
            const float a0 = lo_bf(k1[q]), a1 = hi_bf(k1[q]), b0 = lo_bf(k2[q]), b1 = hi_bf(k2[q]);
            const float co0 = q < 2 ? c0[2 * q] : c1[2 * q - 4], co1 = q < 2 ? c0[2 * q + 1] : c1[2 * q - 3], si0 = q < 2 ? s0[2 * q] : s1[2 * q - 4], si1 = q < 2 ? s0[2 * q + 1] : s1[2 * q - 3];
            Kt[(i8 + 2 * q) * 136 + cc] = f2bf((a0 * co0 - b0 * si0) * zs); Kt[(i8 + 2 * q + 1) * 136 + cc] = f2bf((a1 * co1 - b1 * si1) * zs);
            Kt[(64 + i8 + 2 * q) * 136 + cc] = f2bf((a0 * si0 + b0 * co0) * zs); Kt[(64 + i8 + 2 * q + 1) * 136 + cc] = f2bf((a1 * si1 + b1 * co1) * zs); } }
    __syncthreads();
    float* KV = (float*)(c.ws + WS_KVT) + (size_t)unit * 16384;
    const int ei = w >> 1;
    bf16x8 af[8];
#pragma unroll
    for (int s = 0; s < 8; ++s) af[s] = *(const LAS bf16x8*)((LAS unsigned char*)Vt + (32 * ei + l31) * 272 + (16 * s + 8 * hf) * 2);
#pragma unroll
    for (int dd = 0; dd < 2; ++dd) { const int di = 2 * (w & 1) + dd;
        bf16x8 bf[8];
#pragma unroll
        for (int s = 0; s < 8; ++s) bf[s] = *(const LAS bf16x8*)((LAS unsigned char*)Kt + (32 * di + l31) * 272 + (16 * s + 8 * hf) * 2);
        f32x16 acc;
#pragma unroll
        for (int r = 0; r < 16; ++r) acc[r] = 0.f;
#pragma unroll
        for (int s = 0; s < 8; ++s) acc = MFMA32(af[s], bf[s], acc);
#pragma unroll
        for (int r = 0; r < 16; ++r) KV[(32 * ei + crow(r, hf)) * 128 + 32 * di + l31] = acc[r];
    }
}
DI void ret_scan(const Ctx& c, int item) {
    const int h = item & 3; const int tid = c.tid;
    float* base = (float*)(c.ws + WS_KVT) + (size_t)item * 32 * 16384;
    const float gc = exp2f(128.f * log2f(1.f - exp2f(-5.f - (float)h)));
    f32x4 st[8];
#pragma unroll
    for (int k = 0; k < 8; ++k) st[k] = (f32x4){0.f, 0.f, 0.f, 0.f};
    for (int n = 0; n < 32; ++n) {
        float* slot = base + (size_t)n * 16384;
        f32x4 kv[8];
#pragma unroll
        for (int k = 0; k < 8; ++k) kv[k] = *(const f32x4*)(slot + tid * 4 + 2048 * k);
        asm volatile("s_waitcnt vmcnt(0)" ::: "memory");
        __syncthreads();
#pragma unroll
        for (int k = 0; k < 8; ++k) { u32x2 wv; wv.x = pk2(st[k][0], st[k][1]); wv.y = pk2(st[k][2], st[k][3]); *(u32x2*)((bf16_t*)slot + tid * 4 + 2048 * k) = wv;
            st[k] = st[k] * gc + kv[k]; }
    }
}
constexpr int PH_PER_LAYER = 12, PH_FINAL = 1 + PH_PER_LAYER * DEPTH, N_PHASES = PH_FINAL + 1;
constexpr int LDS_INTAB = LDS_MISC + 64;
DI int qid_of(int l, int k) { return l * 16 + k; }
DI Ctx mkctx(unsigned char* ws, float* out, LAS unsigned char* lds) {
    Ctx c; c.lds = lds; c.misc = (volatile LAS unsigned*)(lds + LDS_MISC); c.ws = ws; c.ctl = (unsigned*)(ws + WS_CTL);
    c.tid = threadIdx.x; c.lane = c.tid & 63; c.wave = __builtin_amdgcn_readfirstlane(c.tid >> 6); c.G = gridDim.x; c.bid = blockIdx.x;
    c.inl = (const LAS unsigned long long*)(lds + LDS_INTAB); c.out = out; return c;
}
#define NOINL __device__ __forceinline__
#define FARGS unsigned char* ws, float* out, LAS unsigned char* lds
#define MK() Ctx c = mkctx(ws, out, lds); asm volatile("" : "+v"(c.tid)); c.lane = c.tid & 63; c.wave = __builtin_amdgcn_readfirstlane(c.tid >> 6); asm volatile("" : "+s"(c.G), "+s"(c.bid)); { unsigned char* w_ = c.ws; asm volatile("" : "+s"(w_)); c.ws = w_; c.ctl = (unsigned*)(w_ + WS_CTL); }
NOINL void f_prologue(FARGS) { MK(); make_tables(c); cvt_mixer0(c); x0_rows(c, INP(IN_X), WSP(bf16_t, WS_H), WSP(float, WS_RSP1), WSP(unsigned char, WS_XB8)); }
NOINL void f_cvt_early(FARGS, int l, int blk) { MK(); cvt_early_block(c, l, blk); }
NOINL void f_final(FARGS) { MK(); final_norm_bf(c, WSP(bf16_t, WS_H), c.out, INP(IN_FINAL_NORM)); }
NOINL void f_gemm_in(FARGS) { MK();
    { int lp = -1; pg8::Sched S8, S16; S8.init(M, 8192, c.G, c.bid, 1); S16.init(M, C_GATE, c.G, c.bid, 1);
      row_factors_units(c, WSP(float, WS_RSP1), WSP(float, WS_RF), S8, lp); row_factors_units(c, WSP(float, WS_RSP1), WSP(float, WS_RF), S16, lp); }
    { pg8::Gemm g{(const bf16_t*)WSP(unsigned char, WS_XB8), (const bf16_t*)WSP(unsigned char, WS_WG8), D / 2, D / 2, 0, 0}; pg8::Sched S; S.init(M, 8192, c.G, c.bid, 1);
      pg8::EpiGate8 E{(unsigned char*)(WSP(bf16_t, WS_PROJ) + C_GATE), (size_t)NP * 2, WSP(float, WS_RF), 0.0078125f}; pg8::gemm_phase<pg8::EpiGate8, true, true>(c.lds, g, S, E, c.tid); }
    asm volatile("" : "+v"(c.tid)); c.lane = c.tid & 63;
    { pg8::Gemm g{WSP(bf16_t, WS_H), WSP(bf16_t, WS_WIN), D, D, 0, 0}; pg8::Sched S; S.init(M, C_GATE, c.G, c.bid, 1);
      pg8::EpiBf16 E{WSP(bf16_t, WS_PROJ), NP, WSP(float, WS_RF), 1 << 30, 1.f}; pg8::gemm_phase<pg8::EpiBf16>(c.lds, g, S, E, c.tid); } }
NOINL void f_gemm_dsaq(FARGS) { MK(); pg8::Gemm g{WSP(bf16_t, WS_PROJ) + C_DCQ, WSP(bf16_t, WS_WDSA), NP, 384, 0, 0}; pg8::Sched S; S.init(M, 1536, c.G, c.bid, 1); pg8::EpiBf16 E{WSP(bf16_t, WS_QD), 1536, nullptr, 1 << 30, 1.f}; pg8::gemm_phase<pg8::EpiBf16>(c.lds, g, S, E, c.tid); }
NOINL void f_gemm_merge(FARGS) { MK(); pg8::Gemm g{WSP(bf16_t, WS_BR), WSP(bf16_t, WS_WBR), D, 512, 512 * 2, (size_t)D * 512 * 2}; pg8::Sched S; S.init(M, D, c.G, c.bid, 4); pg8::EpiMerge E{WSP(bf16_t, WS_RQ), WSP(bf16_t, WS_PROJ)};
    pg8::gemm_phase<pg8::EpiMerge>(c.lds, g, S, E, c.tid); }
NOINL void f_gemm_out(FARGS) { MK(); pg8::Gemm g{WSP(bf16_t, WS_RQ), WSP(bf16_t, WS_WOUT), D, D, 0, 0}; pg8::Sched S; S.init(M, D, c.G, c.bid, 1); pg8::EpiResid E{WSP(bf16_t, WS_H), D, WSP(float, WS_RSP2), nullptr}; pg8::gemm_phase<pg8::EpiResid>(c.lds, g, S, E, c.tid); }
NOINL void f_gemm_gate(FARGS, int l) { MK(); pg8::Gemm g{WSP(bf16_t, WS_H), WSP(bf16_t, WS_WG), D, D, 0, 0}; pg8::Sched S; S.init(M, FF, c.G, c.bid, 1);
    { int lp = -1; row_factors_units(c, WSP(float, WS_RSP2), WSP(float, WS_RF), S, lp); }
    pg8::EpiBf16 E{WSP(bf16_t, WS_G), FF, WSP(float, WS_RF), 1 << 30, 1.f}; pg8::gemm_phase<pg8::EpiBf16>(c.lds, g, S, E, c.tid);
    if (l + 1 < DEPTH && c.bid >= 128) { LAS float* scr = nullptr; const int gw = (c.bid - 128) * 8 + c.wave, NGW = (c.G - 128) * 8;
        for (int it = gw; it < CI_LATE; it += NGW) cvt_late_item(c, l + 1, it, scr); } }
NOINL void f_gemm_up(FARGS, int l) { MK(); pg8::Gemm g{WSP(bf16_t, WS_H), WSP(bf16_t, WS_WU), D, D, 0, 0}; pg8::Sched S; S.init(M, FF, c.G, c.bid, 1);
    pg8::EpiUp E{WSP(bf16_t, WS_ACT), WSP(bf16_t, WS_G), INP(IN_FFN_CONV) + (size_t)l * 3 * FF, INP(IN_FFN_CONVB) + (size_t)l * FF, WSP(float, WS_RF)}; pg8::gemm_phase<pg8::EpiUp>(c.lds, g, S, E, c.tid); }
NOINL void f_gemm_down(FARGS) { MK(); pg8::Gemm g{WSP(bf16_t, WS_ACT), WSP(bf16_t, WS_WD), FF, FF, 0, 0}; pg8::Sched S; S.init(M, D, c.G, c.bid, 1); pg8::EpiResid E{WSP(bf16_t, WS_H), D, WSP(float, WS_RSP1), WSP(unsigned char, WS_XB8)}; pg8::gemm_phase<pg8::EpiResid>(c.lds, g, S, E, c.tid); }
NOINL void f_gdn_prep(FARGS, int l, int it) { MK(); gdn_prep(c, l, it); }
NOINL void f_prep_tok(FARGS, int it) { MK(); prep_tokens(c, it); }
NOINL void f_cfox(FARGS, int l, int it) { MK(); prep_cfox(c, it, l); }
NOINL void f_gdn_scan(FARGS, int it) { MK(); gdn_scan(c, it); }
NOINL void f_idx(FARGS, int b, int q0) { MK(); idx_unit(c, b, q0); }
NOINL void f_attn_fox(FARGS, int l, int b, int h, int q0) { MK(); attn_unit<AT_FOX>(c, l, b, h, q0); }
NOINL void f_attn_ret(FARGS, int l, int b, int h, int q0) { MK(); attn_unit<AT_RET>(c, l, b, h, q0); }
NOINL void f_ret_kv(FARGS, int unit) { MK(); ret_chunk_kv(c, unit); }
NOINL void f_ret_scan(FARGS, int item) { MK(); ret_scan(c, item); }
NOINL void f_attn_dsa(FARGS, int l, int b, int q0) { MK(); attn_unit<AT_DSA>(c, l, b, 0, q0); }
NOINL void f_select(FARGS) { MK(); select_rows(c); }
NOINL void f_gdn_fin(FARGS, int l) { MK(); gdn_finish(c, l); }

__global__ void __launch_bounds__(512, 2) fwd_kernel(Params prm) {
    extern __shared__ __attribute__((aligned(16))) unsigned char lds_raw[];
    LAS unsigned char* lds = (LAS unsigned char*)lds_raw; unsigned char* ws = prm.ws; float* out = prm.out;
    Ctx c = mkctx(ws, out, lds);
    if (c.tid < 16) c.misc[c.tid] = 0u;
    if (c.tid < 21) ((LAS unsigned long long*)(lds + LDS_INTAB))[c.tid] = (unsigned long long)prm.in[c.tid];
    __syncthreads();
    const int lo = prm.ph_lo, hi = prm.ph_hi;
    XcdBarrier bar = xcd_barrier_post(c.ctl + CW_BAR, c.misc + 8);
#define A ws, out, lds
#define LAUNDER() do { asm volatile("" : "+s"(ws), "+s"(out)); unsigned la_ = (unsigned)(size_t)lds; asm volatile("" : "+s"(la_)); lds = (LAS unsigned char*)(size_t)la_; c = mkctx(ws, out, lds); asm volatile("" : "+v"(c.tid)); c.lane = c.tid & 63; } while (0)
#define IN_PH(k) (lo <= (k) && (k) < hi)
#define SEAM(k) do { if (IN_PH(k) && IN_PH((k) + 1)) xcd_barrier(bar); LAUNDER(); } while (0)
    if (IN_PH(0)) f_prologue(A);
    SEAM(0);
    for (int l = 0; l < DEPTH; ++l) {
        const int pb = 1 + PH_PER_LAYER * l;
        if (IN_PH(pb + 1)) f_gemm_in(A);
        SEAM(pb + 1);
        if (IN_PH(pb + 2)) {
            for (;;) { const int it = q_next(c, qid_of(l, 0)); if (it >= 1024) break; f_gdn_prep(A, l, it); }
            LAUNDER();
            for (;;) { const int it = q_next(c, qid_of(l, 9)); if (it >= 512) break; f_ret_kv(A, it); }
            LAUNDER();
            for (;;) { const int it = q_next(c, qid_of(l, 1)); if (it >= 256) break; f_prep_tok(A, it); }
            LAUNDER();
            for (;;) { const int it = q_next(c, qid_of(l, 2)); if (it >= 16) break; f_cfox(A, l, it); }
            LAUNDER();
            __syncthreads();
            f_gemm_dsaq(A);
        }
        SEAM(pb + 2);
        if (IN_PH(pb + 3)) {
            for (;;) { const int it = q_next(c, qid_of(l, 3)); if (it >= 16) break; f_gdn_scan(A, it); }
            LAUNDER();
            for (;;) { const int i = q_next(c, qid_of(l, 4)); if (i >= 512) break; f_idx(A, i & 3, 32 * (127 - (i >> 2))); }
            LAUNDER();
            for (;;) { const int i = q_next(c, qid_of(l, 5)); if (i >= 256) break; f_attn_fox(A, l, (i & 15) >> 2, i & 3, 256 * (15 - (i >> 4))); }
            LAUNDER();
            for (;;) { const int i = q_next(c, qid_of(l, 6)); if (i >= 16) break; f_ret_scan(A, i); }
        }
        SEAM(pb + 3);
        if (IN_PH(pb + 4)) { f_select(A);
            LAUNDER();
            for (;;) { const int i = q_next(c, qid_of(l, 10)); if (i >= 256) break; f_attn_ret(A, l, (i & 15) >> 2, i & 3, 256 * (i >> 4)); } }
        SEAM(pb + 4);
        if (IN_PH(pb + 5)) {
            for (;;) { const int it = q_next(c, qid_of(l, 7)); if (it >= 256) break; f_attn_dsa(A, l, it & 3, 64 * (63 - (it >> 2))); }
            LAUNDER();
            { const int nb = cvt_early_nblk(l); for (;;) { const int it = q_next(c, qid_of(l, 8)); if (it >= nb) break; f_cvt_early(A, l, it); } }
            LAUNDER();
            f_gdn_fin(A, l);
        }
        SEAM(pb + 5);
        if (IN_PH(pb + 6)) f_gemm_merge(A);
        SEAM(pb + 6);
        if (IN_PH(pb + 7)) f_gemm_out(A);
        SEAM(pb + 7);
        if (IN_PH(pb + 9)) f_gemm_gate(A, l);
        SEAM(pb + 9);
        if (IN_PH(pb + 10)) f_gemm_up(A, l);
        SEAM(pb + 10);
        if (IN_PH(pb + 11)) f_gemm_down(A);
        SEAM(pb + 11);
    }
    if (IN_PH(PH_FINAL)) f_final(A);
#undef IN_PH
#undef SEAM
#undef A
}

extern "C" void kernel_launch(void* const* d_in, const int* in_sizes, int n_in, void* d_out, int out_size, void* d_ws, size_t ws_size, hipStream_t stream) {
    static int grid = 0;
    if (grid == 0) {
        if (n_in != 21 || out_size != M * D || ws_size < WS_END) { fprintf(stderr, "kernel_launch: unexpected sizes (n_in %d out %d ws %zu)\n", n_in, out_size, ws_size); grid = -1; return; }
        int dev = 0, cus = 0;
        if (hipGetDevice(&dev) != hipSuccess || hipDeviceGetAttribute(&cus, hipDeviceAttributeMultiprocessorCount, dev) != hipSuccess) { grid = -1; return; }
        if (hipFuncSetAttribute((const void*)fwd_kernel, hipFuncAttributeMaxDynamicSharedMemorySize, LDS_BYTES) != hipSuccess) { fprintf(stderr, "kernel_launch: hipFuncSetAttribute failed\n"); grid = -1; return; }
        int per_cu = 0;
        if (hipOccupancyMaxActiveBlocksPerMultiprocessor(&per_cu, (const void*)fwd_kernel, 512, LDS_BYTES) != hipSuccess || per_cu < 1) { fprintf(stderr, "kernel_launch: occupancy query says %d\n", per_cu); }
        (void)hipGetLastError();
        grid = cus;
    }
    if (grid < 0) return;
    (void)hipMemsetAsync((char*)d_ws + WS_CTL, 0, CTL_BYTES, stream);
    Params p{};
    for (int i = 0; i < 21; ++i) p.in[i] = (const float*)d_in[i];
    p.out = (float*)d_out; p.ws = (unsigned char*)d_ws;
    p.ph_lo = 0; p.ph_hi = N_PHASES;
    hipLaunchKernelGGL(fwd_kernel, dim3(grid), dim3(512), LDS_BYTES, stream, p);
}
```
